# Optimizing an MI355X kernel written in HIP

```python
import jax, jax.numpy as jnp
from jax import lax
import numpy as np

D_MODEL = 1024
BATCH = 8
SEQ = 4096
DEPTH = 4

N_META = 16
EPS = 1e-6
N_BRANCH = 4
POOL_WINDOWS = (2, 4, 8, 16)
POOL_GROUP = 64
POOL_W = POOL_GROUP * 4
MLA_HEADS = 8
QK_NOPE = 64
QK_ROPE = 32
V_DIM = 64
Q_RANK = 256
KV_RANK = 128
ROPE_THETA = 10000.0
MLA_W = MLA_HEADS * V_DIM
Q_BLOCK = 128
CONF_W = 256
CONF_K = 31
SC_W = 256
SC_K = 3

IN_SPLITS = (POOL_W, POOL_W,
             Q_RANK, KV_RANK, QK_ROPE, MLA_W,
             2 * CONF_W, CONF_W,
             3 * SC_W, SC_W,
             N_BRANCH * D_MODEL)
IN_W = sum(IN_SPLITS)

kernel_name = "hybrid_parallel_gated_mixers"


def rms_norm(x, g):
    xf = x.astype(jnp.float32)
    y = xf * lax.rsqrt(jnp.mean(xf * xf, axis=-1, keepdims=True) + EPS)
    return (y * g.astype(jnp.float32)).astype(x.dtype)


def layer_norm(x, g, b):
    xf = x.astype(jnp.float32)
    mu = jnp.mean(xf, axis=-1, keepdims=True)
    var = jnp.mean(jnp.square(xf - mu), axis=-1, keepdims=True)
    y = (xf - mu) * lax.rsqrt(var + EPS)
    return (y * g.astype(jnp.float32) + b.astype(jnp.float32)).astype(x.dtype)


def split_cols(z):
    idx = [int(i) for i in np.cumsum(IN_SPLITS)[:-1]]
    return jnp.split(z, idx, axis=-1)


def causal_dwconv(u, w):
    width, c = w.shape
    up = jnp.pad(u, ((0, 0), (width - 1, 0), (0, 0)))
    return lax.conv_general_dilated(up, w[:, None, :].astype(u.dtype), window_strides=(1,),
                                    padding='VALID', dimension_numbers=('NWC', 'WIO', 'NWC'),
                                    feature_group_count=c)


def rope_tables(n_pos, dim, dtype):
    inv = 1.0 / (ROPE_THETA ** (jnp.arange(0, dim, 2, dtype=jnp.float32) / dim))
    ang = jnp.arange(n_pos, dtype=jnp.float32)[:, None] * inv[None, :]
    return jnp.cos(ang).astype(dtype), jnp.sin(ang).astype(dtype)


def apply_rope(t, cos, sin):
    t1, t2 = jnp.split(t, 2, axis=-1)
    return jnp.concatenate([t1 * cos - t2 * sin, t1 * sin + t2 * cos], axis=-1)


def pool_mixer(v, w_group, scale):
    b_, l_, _ = v.shape
    vf = v.astype(jnp.float32)
    groups = jnp.split(vf, len(POOL_WINDOWS), axis=-1)
    pos = jnp.arange(l_)
    outs = []
    for g, w in zip(groups, POOL_WINDOWS):
        cs = jnp.cumsum(g, axis=1)
        lag = jnp.pad(cs, ((0, 0), (w, 0), (0, 0)))[:, :l_]
        cnt = jnp.minimum(pos + 1, w).astype(jnp.float32)[None, :, None]
        outs.append((cs - lag) / cnt - g)
    p = jnp.stack(outs, axis=2).astype(v.dtype)
    y = jnp.einsum('blgc,gcd->blgd', p, w_group).reshape(b_, l_, POOL_W)
    return y * scale


def mla_attention(c_q, c_kv, k_rope, q_norm_g, w_uq, kv_norm_g, w_ukv, cos, sin):
    b_, l_, _ = c_q.shape
    q = (rms_norm(c_q, q_norm_g) @ w_uq).reshape(b_, l_, MLA_HEADS, QK_NOPE + QK_ROPE)
    q_nope, q_rope = jnp.split(q, [QK_NOPE], axis=-1)
    q_rope = apply_rope(q_rope, cos[:, None, :], sin[:, None, :])
    kv = (rms_norm(c_kv, kv_norm_g) @ w_ukv).reshape(b_, l_, MLA_HEADS, QK_NOPE + V_DIM)
    k_nope, v = jnp.split(kv, [QK_NOPE], axis=-1)
    k_rope = apply_rope(k_rope, cos, sin)
    k = jnp.concatenate([k_nope, jnp.broadcast_to(k_rope[:, :, None, :], (b_, l_, MLA_HEADS, QK_ROPE))], axis=-1)
    qf = jnp.concatenate([q_nope, q_rope], axis=-1) * ((QK_NOPE + QK_ROPE) ** -0.5)
    n_blk = -(-l_ // Q_BLOCK)
    lp = n_blk * Q_BLOCK
    pad = ((0, 0), (0, lp - l_), (0, 0), (0, 0))
    qf, k, v = jnp.pad(qf, pad), jnp.pad(k, pad), jnp.pad(v, pad)
    k_pos = jnp.arange(lp)
    q_blocks = qf.reshape(b_, n_blk, Q_BLOCK, MLA_HEADS, QK_NOPE + QK_ROPE).transpose(1, 0, 2, 3, 4)

    def attend(args):
        qb, i = args
        s = jnp.einsum('bqhd,bkhd->bhqk', qb, k).astype(jnp.float32)
        q_pos = i * Q_BLOCK + jnp.arange(Q_BLOCK)
        s = jnp.where(k_pos[None, :] <= q_pos[:, None], s, -jnp.inf)
        p = jax.nn.softmax(s, axis=-1).astype(v.dtype)
        return jnp.einsum('bhqk,bkhd->bqhd', p, v)

    o = lax.map(attend, (q_blocks, jnp.arange(n_blk)))
    return o.transpose(1, 0, 2, 3, 4).reshape(b_, lp, MLA_W)[:, :l_]


def conformer_conv(u, w_dw, b_dw, ln_g, ln_b):
    a, gate = jnp.split(u, 2, axis=-1)
    z = a * jax.nn.sigmoid(gate)
    z = causal_dwconv(z, w_dw) + b_dw
    z = layer_norm(z, ln_g, ln_b)
    return jax.nn.silu(z)


def short_conv(bcx, w_dw):
    bg, cg, xv = jnp.split(bcx, 3, axis=-1)
    return bg * causal_dwconv(cg * xv, w_dw)


def setup_inputs(seed: int = 0) -> dict:
    key = jax.random.key(seed)
    ks = jax.random.split(key, 24)
    f32 = jnp.float32

    def nrm(k, shape, fan_in):
        return jax.random.normal(k, shape, f32) * (fan_in ** -0.5)

    def gain(k, shape):
        return 1.0 + 0.05 * jax.random.normal(k, shape, f32)

    def bias(k, shape):
        return 0.02 * jax.random.normal(k, shape, f32)

    return {
        "x": jax.random.normal(ks[0], (BATCH, SEQ, D_MODEL), f32),
        "meta_tokens": jax.random.normal(ks[1], (N_META, D_MODEL), f32),
        "pre_norm_g": gain(ks[2], (DEPTH, D_MODEL)),
        "w_in": nrm(ks[3], (DEPTH, D_MODEL, IN_W), D_MODEL),
        "gate_bias": bias(ks[4], (DEPTH, N_BRANCH * D_MODEL)),
        "pool_w": nrm(ks[5], (DEPTH, 4, POOL_GROUP, POOL_GROUP), POOL_GROUP),
        "pool_scale": gain(ks[6], (DEPTH, POOL_W)),
        "w_out_pool": nrm(ks[7], (DEPTH, POOL_W, D_MODEL), POOL_W),
        "q_norm_g": gain(ks[8], (DEPTH, Q_RANK)),
        "w_uq": nrm(ks[9], (DEPTH, Q_RANK, MLA_HEADS * (QK_NOPE + QK_ROPE)), Q_RANK),
        "kv_norm_g": gain(ks[10], (DEPTH, KV_RANK)),
        "w_ukv": nrm(ks[11], (DEPTH, KV_RANK, MLA_HEADS * (QK_NOPE + V_DIM)), KV_RANK),
        "w_out_mla": nrm(ks[12], (DEPTH, MLA_W, D_MODEL), MLA_W),
        "conf_dw_w": nrm(ks[13], (DEPTH, CONF_K, CONF_W), CONF_K),
        "conf_dw_b": bias(ks[14], (DEPTH, CONF_W)),
        "conf_ln_g": gain(ks[15], (DEPTH, CONF_W)),
        "conf_ln_b": bias(ks[16], (DEPTH, CONF_W)),
        "w_out_conf": nrm(ks[17], (DEPTH, CONF_W, D_MODEL), CONF_W),
        "sc_dw_w": nrm(ks[18], (DEPTH, SC_K, SC_W), SC_K),
        "w_out_sc": nrm(ks[19], (DEPTH, SC_W, D_MODEL), SC_W),
        "w_o": nrm(ks[20], (DEPTH, D_MODEL, D_MODEL), D_MODEL),
        "post_norm_g": gain(ks[21], (DEPTH, D_MODEL)),
    }


def reference(x, meta_tokens, pre_norm_g, w_in, gate_bias, pool_w, pool_scale, w_out_pool,
              q_norm_g, w_uq, kv_norm_g, w_ukv, w_out_mla, conf_dw_w, conf_dw_b, conf_ln_g,
              conf_ln_b, w_out_conf, sc_dw_w, w_out_sc, w_o, post_norm_g):
    b_ = x.shape[0]
    meta = jnp.broadcast_to(meta_tokens[None].astype(x.dtype), (b_, N_META, D_MODEL))
    h_res = jnp.concatenate([meta, x], axis=1)
    l_ = h_res.shape[1]
    cos, sin = rope_tables(l_, QK_ROPE, x.dtype)

    for i in range(DEPTH):
        h = rms_norm(h_res, pre_norm_g[i])
        z = h @ w_in[i]
        (pv, pg, cq, ckv, kr, mg, cu, cg, sbcx, sg, gl) = split_cols(z)

        y_a = (pool_mixer(pv, pool_w[i], pool_scale[i]) * jax.nn.silu(pg)) @ w_out_pool[i]
        y_b = (mla_attention(cq, ckv, kr, q_norm_g[i], w_uq[i], kv_norm_g[i], w_ukv[i], cos, sin)
               * jax.nn.silu(mg)) @ w_out_mla[i]
        y_c = (conformer_conv(cu, conf_dw_w[i], conf_dw_b[i], conf_ln_g[i], conf_ln_b[i])
               * jax.nn.silu(cg)) @ w_out_conf[i]
        y_d = (short_conv(sbcx, sc_dw_w[i]) * jax.nn.silu(sg)) @ w_out_sc[i]

        gts = jax.nn.sigmoid(gl + gate_bias[i]).reshape(b_, l_, N_BRANCH, D_MODEL)
        m = (gts[:, :, 0] * y_a + gts[:, :, 1] * y_b + gts[:, :, 2] * y_c + gts[:, :, 3] * y_d)
        h_res = h_res + rms_norm(m @ w_o[i], post_norm_g[i])

    return h_res[:, N_META:]
```

```cpp
#include <hip/hip_runtime.h>
#include <hip/hip_cooperative_groups.h>
#include <cstdio>
#include <cstdint>
namespace cg = cooperative_groups;

#ifndef REP_IN
#define REP_IN 1
#endif
#ifndef REP_QKV
#define REP_QKV 1
#endif
#ifndef REP_WO
#define REP_WO 1
#endif
#ifndef REP_ATTN
#define REP_ATTN 1
#endif
#ifndef REP_MIX
#define REP_MIX 1
#endif
#ifndef REP_MERGE
#define REP_MERGE 1
#endif
#ifndef MULTI_LAUNCH
#define MULTI_LAUNCH 0
#endif

#define LAS __attribute__((address_space(3)))
typedef unsigned short bf16_t;
typedef short bf16x8 __attribute__((ext_vector_type(8)));
typedef short s16x4 __attribute__((ext_vector_type(4)));
typedef float f32x2 __attribute__((ext_vector_type(2)));
typedef float f32x4 __attribute__((ext_vector_type(4)));
typedef float f32x16 __attribute__((ext_vector_type(16)));
typedef unsigned u32x2 __attribute__((ext_vector_type(2)));
typedef unsigned u32x4 __attribute__((ext_vector_type(4)));
typedef __bf16 bf2_t __attribute__((ext_vector_type(2)));

constexpr int LSEQ = 4112, MTOK = 32896, LP = 4224, DM = 1024;
constexpr float EPS = 1e-6f;
constexpr int NLAYER = 4;
constexpr size_t W_IN = 0, W_UQ = 7602176, W_UKV = 7798784, W_OP = 7929856, W_OM = 8192000, W_OC = 8716288, W_OS = 8978432, W_O = 9240576, W_LAYER = 10289152;
constexpr size_t OFF_W = 0;
constexpr size_t OFF_H = OFF_W + W_LAYER * 2 * NLAYER;
constexpr size_t OFF_ZC = OFF_H + (size_t)MTOK * 1024 * 2;
constexpr size_t OFF_ZM = OFF_ZC + (size_t)MTOK * 2304 * 2;
constexpr size_t OFF_U = OFF_ZM + (size_t)MTOK * 1024 * 2;
constexpr size_t OFF_META = OFF_U + (size_t)MTOK * 1280 * 2;
constexpr size_t OFF_ROPE = OFF_META + 128 * 1024 * 4;
constexpr size_t OFF_RS = OFF_ROPE + (size_t)LSEQ * 16 * 2 * 4;
constexpr size_t OFF_SCR = OFF_RS + (size_t)MTOK * 2 * 4;
constexpr size_t OFF_BAR = OFF_SCR + (size_t)512 * 131072;
constexpr size_t OFF_END = OFF_BAR + 16384;
constexpr size_t OFF_Q = OFF_ZC;
constexpr size_t OFF_KN = OFF_Q + (size_t)MTOK * 768 * 2;
constexpr size_t OFF_KR = OFF_KN + (size_t)MTOK * 512 * 2;
constexpr size_t OFF_VT = OFF_KR + (size_t)MTOK * 32 * 2;
static_assert(OFF_VT + (size_t)64 * 64 * LP * 2 <= OFF_ZM, "qkv alias overflow");
static_assert((size_t)257 * 8 * 4 * 16384 <= (size_t)MTOK * 2304 * 2, "u8 gate stash (aliases zc) overflow");

struct Params {
    const float* x; const float* meta; const float* pre_g; const float* w_in; const float* gate_bias;
    const float* pool_w; const float* pool_scale; const float* w_out_pool; const float* q_norm_g; const float* w_uq;
    const float* kv_norm_g; const float* w_ukv; const float* w_out_mla; const float* conf_dw_w; const float* conf_dw_b;
    const float* conf_ln_g; const float* conf_ln_b; const float* w_out_conf; const float* sc_dw_w; const float* w_out_sc;
    const float* w_o; const float* post_g;
    float* out; char* ws;
    int phase_lo, phase_hi;
};

#define DI __device__ __forceinline__
DI float bf2f(bf16_t v) { return __uint_as_float(((unsigned)v) << 16); }
DI float bflo(unsigned v) { return __uint_as_float(v << 16); }
DI float bfhi(unsigned v) { return __uint_as_float(v & 0xffff0000u); }
DI unsigned pk2(float lo, float hi) { f32x2 v = {lo, hi}; bf2_t r = __builtin_convertvector(v, bf2_t); return __builtin_bit_cast(unsigned, r); }
DI bf16_t f2bf(float v) { return (bf16_t)(pk2(v, 0.f) & 0xffffu); }
DI float sigm(float x) { return __builtin_amdgcn_rcpf(1.f + __expf(-x)); }
DI float silu(float x) { return x * __builtin_amdgcn_rcpf(1.f + __expf(-x)); }
DI float wave_sum(float v) {
#pragma unroll
    for (int o = 32; o; o >>= 1) v += __shfl_xor(v, o);
    return v;
}
DI void gload_lds16(const void* g, LAS char* l) { __builtin_amdgcn_global_load_lds((const unsigned*)g, (LAS unsigned*)l, 16, 0, 0); }
DI int otid() { int t = threadIdx.x; asm volatile("" : "+v"(t)); return t; }
DI int vblock() { const int G = gridDim.x; return (G & 7) ? (int)blockIdx.x : (int)((blockIdx.x & 7) * (G >> 3) + (blockIdx.x >> 3)); }

struct GOp { const bf16_t* A; const bf16_t* Bt; int lda, ldb, K, krot; };
DI void gemm_issue(const GOp& g, int kt, LAS char* stage, int w, int lane) {
    const int nk = g.K >> 6;
    const int kk = ((kt + g.krot) & (nk - 1)) * 64;
    LAS char* base = stage + w * 1024;
#pragma unroll
    for (int j = 0; j < 4; ++j) {
        const int o = (j * 4 + w) * 1024 + lane * 16, row = o >> 7, cs = (o >> 4) & 7, c = cs ^ ((row >> 1) & 7);
        gload_lds16(g.A + kk + (unsigned)(row * g.lda + c * 8), base + j * 4096);
        gload_lds16(g.Bt + kk + (unsigned)(row * g.ldb + c * 8), base + 16384 + j * 4096);
    }
}
template <bool WIDE = false>
DI void gemm_core(f32x4 (&acc)[4][4], const GOp& g, LAS char* lds, const int tidx, const bool have_first, const bool has_next, const GOp& gn, const bool fw16 = false) {
    const int tid = tidx, lane = tid & 63, w = tid >> 6, wm = w >> 1, wn = w & 1;
    unsigned oa[4], ob[4];
#pragma unroll
    for (int j = 0; j < 4; ++j) {
        const int o = (j * 4 + w) * 1024 + lane * 16, row = o >> 7, cs = (o >> 4) & 7, c = cs ^ ((row >> 1) & 7);
        oa[j] = (unsigned)(row * g.lda + c * 8); ob[j] = (unsigned)(row * g.ldb + c * 8);
    }
    const int nk = g.K >> 6;
    const int fr = lane & 15, fq = lane >> 4;
    const int sw = (fq ^ (fr >> 1)) << 4;
    const int aoff = (wm * 64 + fr) * 128, boff = 16384 + (wn * 64 + fr) * 128;
    if (!have_first) gemm_issue(g, 0, lds, w, lane);
    for (int kt = 0; kt < nk; ++kt) {
        if (kt == 0 && have_first && fw16) {
            asm volatile("s_waitcnt vmcnt(8) lgkmcnt(0)" ::: "memory");
            __builtin_amdgcn_s_barrier();
            asm volatile("" ::: "memory");
        } else {
            asm volatile("s_waitcnt vmcnt(0)" ::: "memory");
            __syncthreads();
        }
        if (kt + 1 < nk) {
            LAS char* base = lds + ((kt + 1) & 1) * 32768 + w * 1024;
            const int kn = ((kt + 1 + g.krot) & (nk - 1)) * 64;
            const bf16_t* Ak = g.A + kn; const bf16_t* Bk = g.Bt + kn;
#pragma unroll
            for (int j = 0; j < 4; ++j) { gload_lds16(Ak + oa[j], base + j * 4096); gload_lds16(Bk + ob[j], base + 16384 + j * 4096); }
        } else if (has_next) gemm_issue(gn, 0, lds, w, lane);
        LAS char* st = lds + (kt & 1) * 32768;
        if constexpr (WIDE) {
        bf16x8 af[2][4], bfr[2][4];
#pragma unroll
        for (int ks = 0; ks < 2; ++ks) {
#pragma unroll
            for (int i = 0; i < 4; ++i) af[ks][i] = *(LAS bf16x8*)(st + aoff + i * 2048 + (sw ^ (ks * 64)));
#pragma unroll
            for (int i = 0; i < 4; ++i) bfr[ks][i] = *(LAS bf16x8*)(st + boff + i * 2048 + (sw ^ (ks * 64)));
        }
        __builtin_amdgcn_sched_barrier(0);
        __builtin_amdgcn_s_setprio(1);
#pragma unroll
        for (int ks = 0; ks < 2; ++ks)
#pragma unroll
            for (int mi = 0; mi < 4; ++mi)
#pragma unroll
                for (int ni = 0; ni < 4; ++ni) acc[mi][ni] = __builtin_amdgcn_mfma_f32_16x16x32_bf16(bfr[ks][ni], af[ks][mi], acc[mi][ni], 0, 0, 0);
        __builtin_amdgcn_s_setprio(0);
        } else {
#pragma unroll
        for (int ks = 0; ks < 2; ++ks) {
            bf16x8 af[4], bfr[4];
#pragma unroll
            for (int i = 0; i < 4; ++i) af[i] = *(LAS bf16x8*)(st + aoff + i * 2048 + (sw ^ (ks * 64)));
#pragma unroll
            for (int i = 0; i < 4; ++i) bfr[i] = *(LAS bf16x8*)(st + boff + i * 2048 + (sw ^ (ks * 64)));
            __builtin_amdgcn_s_setprio(1);
#pragma unroll
            for (int mi = 0; mi < 4; ++mi)
#pragma unroll
                for (int ni = 0; ni < 4; ++ni) acc[mi][ni] = __builtin_amdgcn_mfma_f32_16x16x32_bf16(bfr[ni], af[mi], acc[mi][ni], 0, 0, 0);
            __builtin_amdgcn_s_setprio(0);
        }
        }
    }
    if (!has_next) __syncthreads();
}
DI void gemm_core(f32x4 (&acc)[4][4], const bf16_t* A, int lda, const bf16_t* Bt, int ldb, int K, LAS char* lds, const int tidx, const int krot = 0) {
    const GOp g{A, Bt, lda, ldb, K, krot};
    gemm_core<false>(acc, g, lds, tidx, false, false, g);
}
DI void store_row_wide(bf16_t* rowbase, const f32x4 (&a)[4], const int fq) {
#pragma unroll
    for (int pr = 0; pr < 2; ++pr) {
        const unsigned x0 = pk2(a[2 * pr][0], a[2 * pr][1]), x1 = pk2(a[2 * pr][2], a[2 * pr][3]);
        const unsigned y0 = pk2(a[2 * pr + 1][0], a[2 * pr + 1][1]), y1 = pk2(a[2 * pr + 1][2], a[2 * pr + 1][3]);
        const auto r0 = __builtin_amdgcn_permlane16_swap(x0, y0, false, false);
        const auto r1 = __builtin_amdgcn_permlane16_swap(x1, y1, false, false);
        *(u32x4*)(rowbase + pr * 32 + (fq & 1) * 16 + (fq >> 1) * 8) = (u32x4){r0[0], r1[0], r0[1], r1[1]};
    }
}
DI void zero_acc(f32x4 (&acc)[4][4]) {
#pragma unroll
    for (int i = 0; i < 4; ++i)
#pragma unroll
        for (int j = 0; j < 4; ++j) acc[i][j] = (f32x4){0.f, 0.f, 0.f, 0.f};
}

DI const float* res_src(const Params& p, int row, bool from_input) {
    const int b = row / LSEQ, t = row - b * LSEQ;
    if (t < 16) return from_input ? p.meta + t * 1024 : (const float*)(p.ws + OFF_META) + (b * 16 + t) * 1024;
    return (from_input ? p.x : (const float*)p.out) + ((size_t)b * 4096 + (t - 16)) * 1024;
}
DI float* res_dst(const Params& p, int row) {
    const int b = row / LSEQ, t = row - b * LSEQ;
    if (t < 16) return (float*)(p.ws + OFF_META) + (b * 16 + t) * 1024;
    return p.out + ((size_t)b * 4096 + (t - 16)) * 1024;
}

DI void phase_norm(const Params& p, int l, int mode) {
    const int tidx = otid();
    const int lane = tidx & 63, w = tidx >> 6;
    bf16_t* h = (bf16_t*)(p.ws + OFF_H);
    const bool from_input = (mode == 0) || (l == 0);
    const bool do_h = (mode == 0) || (l < NLAYER - 1);
    const float* gpost = p.post_g + l * 1024;
    const float* gpre = p.pre_g + (mode == 0 ? 0 : (l + 1 < NLAYER ? l + 1 : 0)) * 1024;
    const int c0 = lane * 8;
    float gp[16], gq[16];
#pragma unroll
    for (int i = 0; i < 16; ++i) { const int c = (i < 8) ? c0 + i : 512 + c0 + (i - 8); gp[i] = gpost[c]; gq[i] = gpre[c]; }
    const int stride = gridDim.x * 4;
    int row = blockIdx.x * 4 + w;
    f32x4 a0, a1, a2, a3; u32x4 o0 = {0u, 0u, 0u, 0u}, o1 = {0u, 0u, 0u, 0u};
    auto load_row = [&](int r, f32x4& b0, f32x4& b1, f32x4& b2, f32x4& b3, u32x4& q0, u32x4& q1) {
        const float* src = res_src(p, r, from_input);
        b0 = *(const f32x4*)(src + c0); b1 = *(const f32x4*)(src + c0 + 4); b2 = *(const f32x4*)(src + 512 + c0); b3 = *(const f32x4*)(src + 512 + c0 + 4);
        if (mode == 1) { const bf16_t* orow = h + (size_t)r * 1024; q0 = *(const u32x4*)(orow + c0); q1 = *(const u32x4*)(orow + 512 + c0); }
    };
    if (row < MTOK) load_row(row, a0, a1, a2, a3, o0, o1);
    while (row < MTOK) {
        const int nrow = row + stride;
        f32x4 n0 = a0, n1 = a1, n2 = a2, n3 = a3; u32x4 m0 = o0, m1 = o1;
        if (nrow < MTOK) load_row(nrow, n0, n1, n2, n3, m0, m1);
        float v[16];
#pragma unroll
        for (int i = 0; i < 4; ++i) { v[i] = a0[i]; v[4 + i] = a1[i]; v[8 + i] = a2[i]; v[12 + i] = a3[i]; }
        if (mode == 1) {
            float ov[16];
#pragma unroll
            for (int i = 0; i < 4; ++i) { ov[2 * i] = bflo(o0[i]); ov[2 * i + 1] = bfhi(o0[i]); ov[8 + 2 * i] = bflo(o1[i]); ov[8 + 2 * i + 1] = bfhi(o1[i]); }
            float ss = 0.f;
#pragma unroll
            for (int i = 0; i < 16; ++i) ss += ov[i] * ov[i];
            ss = wave_sum(ss);
            const float rstd = rsqrtf(ss * (1.f / 1024.f) + EPS);
#pragma unroll
            for (int i = 0; i < 16; ++i) v[i] += ov[i] * rstd * gp[i];
            float* dst = res_dst(p, row);
            *(f32x4*)(dst + c0) = (f32x4){v[0], v[1], v[2], v[3]}; *(f32x4*)(dst + c0 + 4) = (f32x4){v[4], v[5], v[6], v[7]};
            *(f32x4*)(dst + 512 + c0) = (f32x4){v[8], v[9], v[10], v[11]}; *(f32x4*)(dst + 512 + c0 + 4) = (f32x4){v[12], v[13], v[14], v[15]};
        }
        if (do_h) {
            float ss = 0.f;
#pragma unroll
            for (int i = 0; i < 16; ++i) ss += v[i] * v[i];
            ss = wave_sum(ss);
            const float rstd = rsqrtf(ss * (1.f / 1024.f) + EPS);
            float hv[16];
#pragma unroll
            for (int i = 0; i < 16; ++i) hv[i] = v[i] * rstd * gq[i];
            bf16_t* hrow = h + (size_t)row * 1024;
            *(u32x4*)(hrow + c0) = (u32x4){pk2(hv[0], hv[1]), pk2(hv[2], hv[3]), pk2(hv[4], hv[5]), pk2(hv[6], hv[7])};
            *(u32x4*)(hrow + 512 + c0) = (u32x4){pk2(hv[8], hv[9]), pk2(hv[10], hv[11]), pk2(hv[12], hv[13]), pk2(hv[14], hv[15])};
        }
        a0 = n0; a1 = n1; a2 = n2; a3 = n3; o0 = m0; o1 = m1; row = nrow;
    }
}

DI void convT_tile(const float* __restrict__ src, int ldsrc, bf16_t* __restrict__ dst, int K, int tk, int tn, int mode, const float* __restrict__ rowscale, float scale, LAS float* lds, const int tidx) {
    const int t = tidx, nl = t & 63, kq = t >> 6;
    const int np = tn * 64 + nl;
    int col = np;
    if (mode == 1) col = (np < 512) ? np : (np < 2304) ? np + 928 : (np < 3232) ? np - 1792 : (np < 3328) ? -1 : np - 96;
#pragma unroll
    for (int i = 0; i < 16; ++i) {
        const int kl = i * 4 + kq, k = tk * 64 + kl;
        float v = 0.f;
        if (col >= 0) v = src[(size_t)k * ldsrc + col];
        v *= scale;
        if (rowscale) v *= rowscale[k];
        lds[kl * 65 + nl] = v;
    }
    __syncthreads();
#pragma unroll 4
    for (int i = 0; i < 8; ++i) {
        const int nl2 = i * 8 + (t >> 5), kl2 = (t & 31) * 2;
        const unsigned pk = pk2(lds[kl2 * 65 + nl2], lds[(kl2 + 1) * 65 + nl2]);
        *(unsigned*)(dst + (size_t)(tn * 64 + nl2) * K + tk * 64 + kl2) = pk;
    }
    __syncthreads();
}

struct CTile { const float* src; const float* rowscale; bf16_t* dst; int ld, K, tk, tn, mode; float scale; };
DI CTile ct_decode(const Params& p, int i) {
    constexpr int TPL = 2512;
    const int l = i / TPL; int r = i - l * TPL;
    bf16_t* W = (bf16_t*)(p.ws + OFF_W) + (size_t)l * W_LAYER;
    if (r < 1856) return CTile{p.w_in + (size_t)l * 1024 * 7328, nullptr, W + W_IN, 7328, 1024, r & 15, r >> 4, 1, 1.f};
    r -= 1856;
    if (r < 48) return CTile{p.w_uq + (size_t)l * 256 * 768, p.q_norm_g + l * 256, W + W_UQ, 768, 256, r & 3, r >> 2, 0, 0.10206207261596577f * 1.4426950408889634f};
    r -= 48;
    if (r < 32) return CTile{p.w_ukv + (size_t)l * 128 * 1024, p.kv_norm_g + l * 128, W + W_UKV, 1024, 128, r & 1, r >> 1, 0, 1.f};
    r -= 32;
    if (r < 64) return CTile{p.w_out_pool + (size_t)l * 256 * 1024, nullptr, W + W_OP, 1024, 256, r & 3, r >> 2, 0, 1.f};
    r -= 64;
    if (r < 128) return CTile{p.w_out_mla + (size_t)l * 512 * 1024, nullptr, W + W_OM, 1024, 512, r & 7, r >> 3, 0, 1.f};
    r -= 128;
    if (r < 64) return CTile{p.w_out_conf + (size_t)l * 256 * 1024, nullptr, W + W_OC, 1024, 256, r & 3, r >> 2, 0, 1.f};
    r -= 64;
    if (r < 64) return CTile{p.w_out_sc + (size_t)l * 256 * 1024, nullptr, W + W_OS, 1024, 256, r & 3, r >> 2, 0, 1.f};
    r -= 64;
    return CTile{p.w_o + (size_t)l * 1024 * 1024, nullptr, W + W_O, 1024, 1024, r & 15, r >> 4, 0, 1.f};
}
DI void ct_load(const CTile& c, float (&v)[16], const int tidx) {
    const int nl = tidx & 63, kq = tidx >> 6, np = c.tn * 64 + nl;
    int col = np;
    if (c.mode == 1) col = (np < 512) ? np : (np < 2304) ? np + 928 : (np < 3232) ? np - 1792 : (np < 3328) ? -1 : np - 96;
#pragma unroll
    for (int i = 0; i < 16; ++i) {
        const int k = c.tk * 64 + i * 4 + kq;
        float x = 0.f;
        if (col >= 0) x = c.src[(size_t)k * c.ld + col];
        if (c.rowscale) x *= c.rowscale[k];
        v[i] = x;
    }
}
DI void ct_finish(const CTile& c, const float (&v)[16], LAS float* lds, const int tidx) {
    const int t = tidx, nl = t & 63, kq = t >> 6;
#pragma unroll
    for (int i = 0; i < 16; ++i) lds[(i * 4 + kq) * 65 + nl] = v[i] * c.scale;
    __syncthreads();
#pragma unroll
    for (int i = 0; i < 8; ++i) {
        const int nl2 = i * 8 + (t >> 5), kl2 = (t & 31) * 2;
        *(unsigned*)(c.dst + (size_t)(c.tn * 64 + nl2) * c.K + c.tk * 64 + kl2) = pk2(lds[kl2 * 65 + nl2], lds[(kl2 + 1) * 65 + nl2]);
    }
    __syncthreads();
}

DI void phase_init(const Params& p, LAS char* lds) {
    const int tidx = otid();
    {
        constexpr int NTL = 2512 * NLAYER;
        int i = blockIdx.x;
        float v[16], vn[16];
        CTile c = ct_decode(p, i < NTL ? i : 0);
        if (i < NTL) ct_load(c, v, tidx);
        while (i < NTL) {
            const int in = i + gridDim.x;
            const CTile cn = ct_decode(p, in < NTL ? in : i);
            if (in < NTL) ct_load(cn, vn, tidx);
            ct_finish(c, v, (LAS float*)lds, tidx);
#pragma unroll
            for (int j = 0; j < 16; ++j) v[j] = vn[j];
            c = cn; i = in;
        }
    }
    float* rope = (float*)(p.ws + OFF_ROPE);
    for (int i = blockIdx.x * 256 + tidx; i < LSEQ * 16; i += gridDim.x * 256) {
        const int pos = i >> 4, j = i & 15;
        const float inv = exp2f(-(float)j * 0.8304820237218406f);
        double rev = (double)pos * (double)inv * 0.15915494309189535;
        rev -= floor(rev);
        const float rf = (float)rev;
        rope[2 * i] = __builtin_amdgcn_cosf(rf); rope[2 * i + 1] = __builtin_amdgcn_sinf(rf);
    }
    phase_norm(p, 0, 0);
}

DI void phase_gemm_in(const Params& p, int l, LAS char* lds) {
    const int tidx = otid();
    const bf16_t* h = (const bf16_t*)(p.ws + OFF_H);
    const bf16_t* W = (const bf16_t*)(p.ws + OFF_W) + (size_t)l * W_LAYER + W_IN;
    bf16_t* zc = (bf16_t*)(p.ws + OFF_ZC); bf16_t* zm = (bf16_t*)(p.ws + OFF_ZM);
    const int lane = tidx & 63, w = tidx >> 6, wm = w >> 1, wn = w & 1, fr = lane & 15, fq = lane >> 4;
    auto tile_of = [&](int i, int& mt, int& nt) {
        if (i < 3 * 2056) { const int ng = i / 2056, r = i - ng * 2056; mt = r >> 3; nt = ng * 8 + (r & 7); }
        else { const int r = i - 3 * 2056; mt = r >> 1; nt = 24 + (r & 1); }
    };
    auto op_of = [&](int i) { int mt, nt; tile_of(i, mt, nt); return GOp{h + (size_t)mt * 128 * 1024, W + (size_t)nt * 128 * 1024, 1024, 1024, 1024, 2 * (mt + nt)}; };
    bool inflight = false;
    for (int i = vblock(); i < 257 * 26; i += gridDim.x) {
        int mt, nt; tile_of(i, mt, nt);
        const bool has_next = i + (int)gridDim.x < 257 * 26;
        const GOp g = op_of(i), gn = op_of(has_next ? i + (int)gridDim.x : i);
        f32x4 acc[4][4]; zero_acc(acc);
        gemm_core<true>(acc, g, lds, tidx, inflight, has_next, gn, true);
        inflight = has_next;
#pragma unroll
        for (int mi = 0; mi < 4; ++mi) {
            const int row = mt * 128 + wm * 64 + mi * 16 + fr;
            const int col0 = nt * 128 + wn * 64;
            store_row_wide((nt < 18) ? zc + (size_t)row * 2304 + col0 : zm + (size_t)row * 1024 + (col0 - 2304), acc[mi], fq);
        }
    }
}

DI void phase_mixers(const Params& p, int l, LAS char* lds) {
    const int tidx = otid();
    {
        const bf16_t* zmr = (const bf16_t*)(p.ws + OFF_ZM);
        float* rsb = (float*)(p.ws + OFF_RS);
        const int ln = tidx & 63, wv = tidx >> 6, stride = gridDim.x * 4;
        for (int row0 = blockIdx.x * 4 + wv; row0 < MTOK; row0 += 4 * stride) {
            u32x2 a[4]; unsigned b[4];
#pragma unroll
            for (int j = 0; j < 4; ++j) {
                const int row = (row0 + j * stride < MTOK) ? row0 + j * stride : row0;
                a[j] = *(const u32x2*)(zmr + (size_t)row * 1024 + ln * 4);
                b[j] = *(const unsigned*)(zmr + (size_t)row * 1024 + 256 + ln * 2);
            }
            float sq[4], sk[4];
#pragma unroll
            for (int j = 0; j < 4; ++j) {
                sq[j] = bflo(a[j][0]) * bflo(a[j][0]) + bfhi(a[j][0]) * bfhi(a[j][0]) + bflo(a[j][1]) * bflo(a[j][1]) + bfhi(a[j][1]) * bfhi(a[j][1]);
                sk[j] = bflo(b[j]) * bflo(b[j]) + bfhi(b[j]) * bfhi(b[j]);
            }
#pragma unroll
            for (int o = 32; o; o >>= 1) {
#pragma unroll
                for (int j = 0; j < 4; ++j) { sq[j] += __shfl_xor(sq[j], o); sk[j] += __shfl_xor(sk[j], o); }
            }
#pragma unroll
            for (int j = 0; j < 4; ++j) {
                const int row = row0 + j * stride;
                if (ln == 0 && row < MTOK) *(f32x2*)(rsb + (size_t)row * 2) = (f32x2){rsqrtf(sq[j] * (1.f / 256.f) + EPS), rsqrtf(sk[j] * (1.f / 128.f) + EPS)};
            }
        }
    }
    LAS float* ybuf = (LAS float*)lds;
    const bf16_t* zc = (const bf16_t*)(p.ws + OFF_ZC);
    bf16_t* u = (bf16_t*)(p.ws + OFF_U);
    const int c = tidx, w = c >> 6, lane = c & 63;
    const float* scw = p.sc_dw_w + l * 3 * 256;
    const float* cw = p.conf_dw_w + l * 31 * 256;
    for (int tile = vblock(); tile < 8 * 129; tile += gridDim.x) {
        const int b = tile / 129, t0 = (tile - b * 129) * 32;
        const bf16_t* zb = zc + (size_t)b * LSEQ * 2304;
        bf16_t* ub = u + (size_t)b * LSEQ * 1280;
        {
            asm volatile("" ::: "memory");
            const int c8 = (c & 31) * 8, tb = t0 + (c >> 5) * 4;
            float w0[8], w1[8], w2[8];
            {
                const f32x4 a0 = *(const f32x4*)(scw + c8), a1 = *(const f32x4*)(scw + c8 + 4), b0 = *(const f32x4*)(scw + 256 + c8), b1 = *(const f32x4*)(scw + 256 + c8 + 4);
                const f32x4 d0 = *(const f32x4*)(scw + 512 + c8), d1 = *(const f32x4*)(scw + 512 + c8 + 4);
#pragma unroll
                for (int e = 0; e < 4; ++e) { w0[e] = a0[e]; w0[4 + e] = a1[e]; w1[e] = b0[e]; w1[4 + e] = b1[e]; w2[e] = d0[e]; w2[4 + e] = d1[e]; }
            }
            u32x4 cgr[6], xvr[6], bgr[4], sgr[4];
#pragma unroll
            for (int i = 0; i < 6; ++i) {
                const int t = tb - 2 + i;
                cgr[i] = (u32x4){0u, 0u, 0u, 0u}; xvr[i] = (u32x4){0u, 0u, 0u, 0u};
                if (t >= 0 && t < LSEQ) { const bf16_t* r = zb + (size_t)t * 2304; cgr[i] = *(const u32x4*)(r + 1536 + c8); xvr[i] = *(const u32x4*)(r + 1792 + c8); }
            }
#pragma unroll
            for (int i = 0; i < 4; ++i) {
                const int t = tb + i, tc = (t < LSEQ) ? t : LSEQ - 1;
                const bf16_t* r = zb + (size_t)tc * 2304;
                bgr[i] = *(const u32x4*)(r + 1280 + c8); sgr[i] = *(const u32x4*)(r + 2048 + c8);
            }
            float pr[6][8];
#pragma unroll
            for (int i = 0; i < 6; ++i)
#pragma unroll
                for (int e = 0; e < 4; ++e) { pr[i][2 * e] = bflo(cgr[i][e]) * bflo(xvr[i][e]); pr[i][2 * e + 1] = bfhi(cgr[i][e]) * bfhi(xvr[i][e]); }
#pragma unroll
            for (int j = 0; j < 4; ++j) {
                const int t = tb + j;
                float o[8];
#pragma unroll
                for (int e = 0; e < 8; ++e) {
                    const float bg = (e & 1) ? bfhi(bgr[j][e >> 1]) : bflo(bgr[j][e >> 1]), sg = (e & 1) ? bfhi(sgr[j][e >> 1]) : bflo(sgr[j][e >> 1]);
                    o[e] = bg * (w0[e] * pr[j][e] + w1[e] * pr[j + 1][e] + w2[e] * pr[j + 2][e]) * silu(sg);
                }
                if (t < LSEQ) *(u32x4*)(ub + (size_t)t * 1280 + 1024 + c8) = (u32x4){pk2(o[0], o[1]), pk2(o[2], o[3]), pk2(o[4], o[5]), pk2(o[6], o[7])};
            }
        }
    }
    for (int tile = vblock(); tile < 8 * 129; tile += gridDim.x) {
        const int b = tile / 129, t0 = (tile - b * 129) * 32;
        const bf16_t* zb = zc + (size_t)b * LSEQ * 2304;
        bf16_t* ub = u + (size_t)b * LSEQ * 1280;
        {
            asm volatile("" ::: "memory");
            LAS bf16_t* gl = (LAS bf16_t*)(lds + 32768);
            {
                u32x4 av[8], gv[8];
#pragma unroll
                for (int it = 0; it < 8; ++it) {
                    const int q = c + 256 * it, r = q >> 5, c8 = (q & 31) * 8, t = t0 - 30 + r;
                    av[it] = (u32x4){0u, 0u, 0u, 0u}; gv[it] = (u32x4){0u, 0u, 0u, 0u};
                    if (q < 62 * 32 && t >= 0 && t < LSEQ) { const bf16_t* rp = zb + (size_t)t * 2304; av[it] = *(const u32x4*)(rp + 512 + c8); gv[it] = *(const u32x4*)(rp + 768 + c8); }
                }
#pragma unroll
                for (int it = 0; it < 8; ++it) {
                    const int q = c + 256 * it, r = q >> 5, c8 = (q & 31) * 8;
                    u32x4 o;
#pragma unroll
                    for (int e = 0; e < 4; ++e) o[e] = pk2(bflo(av[it][e]) * sigm(bflo(gv[it][e])), bfhi(av[it][e]) * sigm(bfhi(gv[it][e])));
                    if (q < 62 * 32) *(LAS u32x4*)(gl + r * 256 + c8) = o;
                }
            }
            __syncthreads();
            {
                float wk[31];
#pragma unroll
                for (int k = 0; k < 31; ++k) wk[k] = cw[k * 256 + c];
                const float bias = p.conf_dw_b[l * 256 + c];
                float g[62];
#pragma unroll
                for (int i = 0; i < 62; ++i) g[i] = bf2f(gl[i * 256 + c]);
#pragma unroll
                for (int tt = 0; tt < 32; ++tt) {
                    float y = bias;
#pragma unroll
                    for (int k = 0; k < 31; ++k) y += wk[k] * g[tt + k];
                    ybuf[tt * 256 + c] = y;
                }
            }
            __syncthreads();
            const f32x4 lng = *(const f32x4*)(p.conf_ln_g + l * 256 + lane * 4), lnb = *(const f32x4*)(p.conf_ln_b + l * 256 + lane * 4);
            u32x2 cgp[8]; f32x4 v[8]; float s1[8], s2[8];
#pragma unroll
            for (int j = 0; j < 8; ++j) {
                const int t = t0 + w * 8 + j, tc = (t < LSEQ) ? t : LSEQ - 1;
                cgp[j] = *(const u32x2*)(zb + (size_t)tc * 2304 + 1024 + lane * 4);
                v[j] = *(LAS f32x4*)(ybuf + (w * 8 + j) * 256 + lane * 4);
                s1[j] = (v[j][0] + v[j][1]) + (v[j][2] + v[j][3]);
            }
#pragma unroll
            for (int o = 32; o; o >>= 1) {
#pragma unroll
                for (int j = 0; j < 8; ++j) s1[j] += __shfl_xor(s1[j], o);
            }
#pragma unroll
            for (int j = 0; j < 8; ++j) { v[j] = v[j] - s1[j] * (1.f / 256.f); s2[j] = (v[j][0] * v[j][0] + v[j][1] * v[j][1]) + (v[j][2] * v[j][2] + v[j][3] * v[j][3]); }
#pragma unroll
            for (int o = 32; o; o >>= 1) {
#pragma unroll
                for (int j = 0; j < 8; ++j) s2[j] += __shfl_xor(s2[j], o);
            }
#pragma unroll
            for (int j = 0; j < 8; ++j) {
                const int t = t0 + w * 8 + j;
                const float rstd = rsqrtf(s2[j] * (1.f / 256.f) + EPS);
                if (t < LSEQ) {
                    const f32x4 d = v[j]; const u32x2 cgv = cgp[j];
                    const float o0 = silu(d[0] * rstd * lng[0] + lnb[0]) * silu(bflo(cgv[0]));
                    const float o1 = silu(d[1] * rstd * lng[1] + lnb[1]) * silu(bfhi(cgv[0]));
                    const float o2 = silu(d[2] * rstd * lng[2] + lnb[2]) * silu(bflo(cgv[1]));
                    const float o3 = silu(d[3] * rstd * lng[3] + lnb[3]) * silu(bfhi(cgv[1]));
                    *(u32x2*)(ub + (size_t)t * 1280 + 768 + lane * 4) = (u32x2){pk2(o0, o1), pk2(o2, o3)};
                }
            }
            __syncthreads();
        }
    }
    for (int tile = vblock(); tile < 8 * 129; tile += gridDim.x) {
        const int b = tile / 129, t0 = (tile - b * 129) * 32;
        const bf16_t* zb = zc + (size_t)b * LSEQ * 2304;
        bf16_t* ub = u + (size_t)b * LSEQ * 1280;
        {
            const int win = 2 << w;
            LAS bf16_t* img = (LAS bf16_t*)(lds + 32768);
            u32x4 pgr[4];
            {
                u32x4 vv[6];
#pragma unroll
                for (int it = 0; it < 6; ++it) {
                    const int q = c + 256 * it, r = q >> 5, c8 = (q & 31) * 8, t = t0 - 15 + r;
                    vv[it] = (u32x4){0u, 0u, 0u, 0u};
                    if (q < 47 * 32 && t >= 0 && t < LSEQ) vv[it] = *(const u32x4*)(zb + (size_t)t * 2304 + c8);
                }
#pragma unroll
                for (int it = 0; it < 4; ++it) {
                    const int q = c + 256 * it, r = q >> 5, c8 = (q & 31) * 8, t = t0 + r, tc = (t < LSEQ) ? t : LSEQ - 1;
                    pgr[it] = *(const u32x4*)(zb + (size_t)tc * 2304 + 256 + c8);
                }
#pragma unroll
                for (int it = 0; it < 6; ++it) {
                    const int q = c + 256 * it, r = q >> 5, c8 = (q & 31) * 8;
                    if (q < 47 * 32) *(LAS u32x4*)(img + r * 256 + c8) = vv[it];
                }
            }
            __syncthreads();
            {
                float v[47];
#pragma unroll
                for (int i = 0; i < 47; ++i) v[i] = bf2f(img[i * 256 + c]);
#pragma unroll
                for (int tt = 0; tt < 32; ++tt) {
                    float s = 0.f;
#pragma unroll
                    for (int j = 0; j < 16; ++j) s += (j < win) ? v[tt + 15 - j] : 0.f;
                    const int t = t0 + tt;
                    const float cnt = (float)((t + 1 < win) ? t + 1 : win);
                    ybuf[tt * 256 + c] = s * __builtin_amdgcn_rcpf(cnt) - v[tt + 15];
                }
            }
            __syncthreads();
#pragma unroll
            for (int it = 0; it < 4; ++it) { const int q = c + 256 * it, r = q >> 5, c8 = (q & 31) * 8; *(LAS u32x4*)(img + r * 256 + c8) = pgr[it]; }
            __syncthreads();
            asm volatile("" ::: "memory");
            float W[64];
            const float* pw = p.pool_w + ((size_t)(l * 4 + w) * 64) * 64 + lane;
#pragma unroll
            for (int cc = 0; cc < 64; ++cc) W[cc] = pw[cc * 64];
            const float scale = p.pool_scale[l * 256 + c];
            for (int tt = 0; tt < 32; ++tt) {
                const int t = t0 + tt;
                float y = 0.f;
#pragma unroll
                for (int c4 = 0; c4 < 16; ++c4) {
                    const f32x4 pp = *(LAS f32x4*)(ybuf + tt * 256 + w * 64 + c4 * 4);
                    y += pp[0] * W[4 * c4] + pp[1] * W[4 * c4 + 1] + pp[2] * W[4 * c4 + 2] + pp[3] * W[4 * c4 + 3];
                }
                if (t < LSEQ) ub[(size_t)t * 1280 + c] = f2bf(y * scale * silu(bf2f(img[tt * 256 + c])));
            }
            __syncthreads();
        }
    }
}

DI void phase_qkv(const Params& p, int l, LAS char* lds) {
    const int tidx = otid();
    const bf16_t* zm = (const bf16_t*)(p.ws + OFF_ZM);
    const bf16_t* W = (const bf16_t*)(p.ws + OFF_W) + (size_t)l * W_LAYER;
    bf16_t* Q = (bf16_t*)(p.ws + OFF_Q); bf16_t* Kn = (bf16_t*)(p.ws + OFF_KN); bf16_t* Kr = (bf16_t*)(p.ws + OFF_KR); bf16_t* Vt = (bf16_t*)(p.ws + OFF_VT);
    const float* rope = (const float*)(p.ws + OFF_ROPE);
    const int tid = tidx, lane = tid & 63, w = tid >> 6, wm = w >> 1, wn = w & 1, fr = lane & 15, fq = lane >> 4;
    const float* rsb = (const float*)(p.ws + OFF_RS);
    auto op_of = [&](int i) {
        const int mt = i / 14, nt = i - mt * 14;
        if (nt < 6) return GOp{zm + (size_t)mt * 128 * 1024, W + W_UQ + (size_t)nt * 128 * 256, 1024, 256, 256, mt + nt};
        return GOp{zm + (size_t)mt * 128 * 1024 + 256, W + W_UKV + (size_t)(nt - 6) * 128 * 128, 1024, 128, 128, mt + nt};
    };
    bool inflight = false;
    for (int i = vblock(); i < 257 * 14; i += gridDim.x) {
        const int mt = i / 14, nt = i - mt * 14;
        const bool isq = nt < 6;
        const int m0 = mt * 128;
        const bool has_next = i + (int)gridDim.x < 257 * 14;
        const GOp g = op_of(i), gn = op_of(has_next ? i + (int)gridDim.x : i);
        float rr[4];
#pragma unroll
        for (int mi = 0; mi < 4; ++mi) rr[mi] = rsb[(size_t)(m0 + wm * 64 + mi * 16 + fr) * 2 + (isq ? 0 : 1)];
        f32x4 acc[4][4]; zero_acc(acc);
        gemm_core(acc, g, lds, tidx, inflight, has_next, gn);
        inflight = has_next;
        if (isq) {
            const int cb0 = (nt * 128 + wn * 64) >> 4;
#pragma unroll
            for (int mi = 0; mi < 4; ++mi) {
                const int row = m0 + wm * 64 + mi * 16 + fr;
                const int pos = row % LSEQ;
#pragma unroll
                for (int ni = 0; ni < 4; ++ni) acc[mi][ni] = acc[mi][ni] * rr[mi];
#pragma unroll
                for (int ni = 0; ni < 4; ni += 2) {
                    if ((cb0 + ni) % 6 == 4) {
#pragma unroll
                        for (int r = 0; r < 4; ++r) {
                            const f32x2 cs = *(const f32x2*)(rope + ((size_t)pos * 16 + fq * 4 + r) * 2);
                            const float t1 = acc[mi][ni][r], t2 = acc[mi][ni + 1][r];
                            acc[mi][ni][r] = t1 * cs[0] - t2 * cs[1]; acc[mi][ni + 1][r] = t1 * cs[1] + t2 * cs[0];
                        }
                    }
                }
#pragma unroll
                for (int ni = 0; ni < 4; ++ni) {
                    const int col = nt * 128 + wn * 64 + ni * 16 + fq * 4;
                    *(u32x2*)(Q + (size_t)row * 768 + col) = (u32x2){pk2(acc[mi][ni][0], acc[mi][ni][1]), pk2(acc[mi][ni][2], acc[mi][ni][3])};
                }
            }
        } else {
            const int ntk = nt - 6;
            const int cbase = ntk * 128 + wn * 64, hd = cbase >> 7, isv = (cbase >> 6) & 1;
#pragma unroll
            for (int mi = 0; mi < 4; ++mi) {
                const int row = m0 + wm * 64 + mi * 16 + fr;
                const int b = row / LSEQ, t = row - b * LSEQ;
#pragma unroll
                for (int ni = 0; ni < 4; ++ni) {
                    const f32x4 v = acc[mi][ni] * rr[mi];
                    const int d = ni * 16 + fq * 4;
                    if (!isv) {
                        *(u32x2*)(Kn + (size_t)row * 512 + hd * 64 + d) = (u32x2){pk2(v[0], v[1]), pk2(v[2], v[3])};
                    } else {
                        bf16_t* vp = Vt + ((size_t)((b * 8 + hd) * 64 + d)) * LP + t;
                        vp[0] = f2bf(v[0]); vp[LP] = f2bf(v[1]); vp[2 * LP] = f2bf(v[2]); vp[3 * LP] = f2bf(v[3]);
                    }
                }
            }
        }
    }
    for (int i = blockIdx.x * 256 + tid; i < MTOK * 16; i += gridDim.x * 256) {
        const int row = i >> 4, j = i & 15, pos = row % LSEQ;
        const bf16_t* kr = zm + (size_t)row * 1024 + 384;
        const float t1 = bf2f(kr[j]), t2 = bf2f(kr[16 + j]);
        const f32x2 cs = *(const f32x2*)(rope + ((size_t)pos * 16 + j) * 2);
        Kr[(size_t)row * 32 + j] = f2bf(t1 * cs[0] - t2 * cs[1]);
        Kr[(size_t)row * 32 + 16 + j] = f2bf(t1 * cs[1] + t2 * cs[0]);
    }
    for (int i = blockIdx.x * 256 + tid; i < 64 * 64 * (LP - LSEQ); i += gridDim.x * 256) {
        const int r = i / (LP - LSEQ), k = i - r * (LP - LSEQ);
        Vt[(size_t)r * LP + LSEQ + k] = 0;
    }
}

DI int crow(int r, int hh) { return (r & 3) + 8 * (r >> 2) + 4 * hh; }
DI void phase_attn(const Params& p, int l, LAS char* lds) {
    const int tidx = otid();
    const bf16_t* Q = (const bf16_t*)(p.ws + OFF_Q); const bf16_t* Kn = (const bf16_t*)(p.ws + OFF_KN);
    const bf16_t* Kr = (const bf16_t*)(p.ws + OFF_KR); const bf16_t* Vt = (const bf16_t*)(p.ws + OFF_VT);
    const bf16_t* zm = (const bf16_t*)(p.ws + OFF_ZM);
    bf16_t* u = (bf16_t*)(p.ws + OFF_U);
    const int tid = tidx, lane = tid & 63, w = tid >> 6, qi = lane & 31, hh = lane >> 5;
    const int G = gridDim.x;
    constexpr int NUNITS = 64 * 33;
    int krow_[3], kc_[3];
#pragma unroll
    for (int j = 0; j < 3; ++j) {
        const int o = (j * 4 + w) * 1024 + lane * 16;
        krow_[j] = o / 192; const int cs = (o - krow_[j] * 192) >> 4; kc_[j] = cs ^ ((krow_[j] >> 2) & 3);
    }
    int vrow_[2], vc_[2];
#pragma unroll
    for (int j = 0; j < 2; ++j) {
        const int o = (j * 4 + w) * 1024 + lane * 16;
        vrow_[j] = o >> 7; const int cs = (o >> 4) & 7; vc_[j] = cs ^ ((vrow_[j] >> 1) & 7);
    }
    const int ksw = (qi >> 2) & 3;
    const int vsw = (qi >> 1) & 7;
    for (int k = 0; k * G < NUNITS; ++k) {
        const int unit = k * G + ((k & 1) ? (G - 1 - (int)blockIdx.x) : (int)blockIdx.x);
        if (unit >= NUNITS) continue;
        const int qt = 32 - unit / 64, bh = unit & 63, b = bh >> 3, hd = bh & 7;
        const int q0w = qt * 128 + w * 32;
        const int nkt = (2 * qt + 2 < 65) ? 2 * qt + 2 : 65;
        bf16x8 qf[6];
        {
            const int tq = (q0w + qi < LSEQ) ? q0w + qi : LSEQ - 1;
            const bf16_t* qp = Q + ((size_t)(b * LSEQ + tq)) * 768 + hd * 96 + 8 * hh;
#pragma unroll
            for (int s = 0; s < 6; ++s) qf[s] = *(const bf16x8*)(qp + 16 * s);
        }
        const bf16_t* Knb = Kn + (size_t)b * LSEQ * 512 + hd * 64;
        const bf16_t* Krb = Kr + (size_t)b * LSEQ * 32;
        const bf16_t* Vtb = Vt + (size_t)bh * 64 * LP;
        auto issue = [&](int stage, int kt) {
            LAS char* base = lds + stage * 20480 + w * 1024;
#pragma unroll
            for (int j = 0; j < 3; ++j) {
                int tk = kt * 64 + krow_[j]; tk = (tk < LSEQ) ? tk : LSEQ - 1;
                const bf16_t* src = (kc_[j] < 8) ? Knb + (size_t)tk * 512 + kc_[j] * 8 : Krb + (size_t)tk * 32 + (kc_[j] - 8) * 8;
                gload_lds16(src, base + j * 4096);
            }
#pragma unroll
            for (int j = 0; j < 2; ++j) gload_lds16(Vtb + (size_t)vrow_[j] * LP + kt * 64 + vc_[j] * 8, base + 12288 + j * 4096);
        };
        f32x16 o0, o1;
#pragma unroll
        for (int r = 0; r < 16; ++r) { o0[r] = 0.f; o1[r] = 0.f; }
        float m_run = -INFINITY, l_run = 0.f;
        issue(0, 0);
        for (int kt = 0; kt < nkt; ++kt) {
            asm volatile("s_waitcnt vmcnt(0)" ::: "memory");
            __syncthreads();
            if (kt + 1 < nkt) issue((kt + 1) & 1, kt + 1);
            if (kt * 64 > q0w + 31) continue;
            LAS char* st = lds + (kt & 1) * 20480;
            f32x16 s0, s1;
#pragma unroll
            for (int r = 0; r < 16; ++r) { s0[r] = 0.f; s1[r] = 0.f; }
#pragma unroll
            for (int s = 0; s < 6; ++s) {
                const int pos = ((2 * s + hh) ^ ksw) << 4;
                const bf16x8 k0 = *(LAS bf16x8*)(st + qi * 192 + pos);
                const bf16x8 k1 = *(LAS bf16x8*)(st + (qi + 32) * 192 + pos);
                s0 = __builtin_amdgcn_mfma_f32_32x32x16_bf16(k0, qf[s], s0, 0, 0, 0);
                s1 = __builtin_amdgcn_mfma_f32_32x32x16_bf16(k1, qf[s], s1, 0, 0, 0);
            }
            if (kt * 64 + 63 > q0w) {
                const int qpos = q0w + qi;
#pragma unroll
                for (int r = 0; r < 16; ++r) {
                    const int key = kt * 64 + crow(r, hh);
                    if (key > qpos) s0[r] = -INFINITY;
                    if (key + 32 > qpos) s1[r] = -INFINITY;
                }
            }
            __builtin_amdgcn_s_setprio(1);
            float mx = s0[0];
#pragma unroll
            for (int r = 1; r < 16; ++r) mx = fmaxf(mx, s0[r]);
#pragma unroll
            for (int r = 0; r < 16; ++r) mx = fmaxf(mx, s1[r]);
            {
                const auto rr = __builtin_amdgcn_permlane32_swap(__float_as_uint(mx), __float_as_uint(mx), false, false);
                mx = fmaxf(__uint_as_float(rr[0]), __uint_as_float(rr[1]));
            }
            float m_new = m_run;
            if (__builtin_amdgcn_ballot_w64(mx - m_run > 8.f) != 0ull) {
                m_new = fmaxf(m_run, mx);
                const float alpha = __builtin_amdgcn_exp2f(m_run - m_new);
                m_run = m_new;
                l_run *= alpha;
#pragma unroll
                for (int r = 0; r < 16; ++r) { o0[r] *= alpha; o1[r] *= alpha; }
            }
            float ps = 0.f;
#pragma unroll
            for (int r = 0; r < 16; ++r) { s0[r] = __builtin_amdgcn_exp2f(s0[r] - m_new); s1[r] = __builtin_amdgcn_exp2f(s1[r] - m_new); ps += s0[r] + s1[r]; }
            l_run += ps;
            bf16x8 pf[2][2];
#pragma unroll
            for (int s2 = 0; s2 < 2; ++s2) {
                u32x4 a, c2;
#pragma unroll
                for (int e = 0; e < 4; ++e) { a[e] = pk2(s0[8 * s2 + 2 * e], s0[8 * s2 + 2 * e + 1]); c2[e] = pk2(s1[8 * s2 + 2 * e], s1[8 * s2 + 2 * e + 1]); }
                pf[0][s2] = __builtin_bit_cast(bf16x8, a); pf[1][s2] = __builtin_bit_cast(bf16x8, c2);
            }
            LAS char* vs = st + 12288;
            __builtin_amdgcn_s_setprio(0);
#pragma unroll
            for (int tl = 0; tl < 2; ++tl)
#pragma unroll
                for (int s2 = 0; s2 < 2; ++s2) {
                    const int c = 4 * tl + 2 * s2;
                    const int p0 = ((c ^ vsw) << 4) + 8 * hh, p1 = (((c + 1) ^ vsw) << 4) + 8 * hh;
                    const s16x4 a0 = *(LAS s16x4*)(vs + qi * 128 + p0), a1 = *(LAS s16x4*)(vs + qi * 128 + p1);
                    const s16x4 b0 = *(LAS s16x4*)(vs + (qi + 32) * 128 + p0), b1 = *(LAS s16x4*)(vs + (qi + 32) * 128 + p1);
                    const bf16x8 v0 = __builtin_shufflevector(a0, a1, 0, 1, 2, 3, 4, 5, 6, 7);
                    const bf16x8 v1 = __builtin_shufflevector(b0, b1, 0, 1, 2, 3, 4, 5, 6, 7);
                    o0 = __builtin_amdgcn_mfma_f32_32x32x16_bf16(v0, pf[tl][s2], o0, 0, 0, 0);
                    o1 = __builtin_amdgcn_mfma_f32_32x32x16_bf16(v1, pf[tl][s2], o1, 0, 0, 0);
                }
        }
        __syncthreads();
        const float lt = l_run + __shfl_xor(l_run, 32);
        const float inv = 1.f / lt;
        const int t = q0w + qi;
        if (t < LSEQ) {
            const size_t row = (size_t)b * LSEQ + t;
            const bf16_t* mg = zm + row * 1024 + 416 + hd * 64;
            bf16_t* dst = u + row * 1280 + 256 + hd * 64;
#pragma unroll
            for (int g = 0; g < 4; ++g) {
                const int d = 8 * g + 4 * hh;
                const u32x2 g0 = *(const u32x2*)(mg + d), g1 = *(const u32x2*)(mg + 32 + d);
                *(u32x2*)(dst + d) = (u32x2){pk2(o0[4 * g] * inv * silu(bflo(g0[0])), o0[4 * g + 1] * inv * silu(bfhi(g0[0]))),
                                             pk2(o0[4 * g + 2] * inv * silu(bflo(g0[1])), o0[4 * g + 3] * inv * silu(bfhi(g0[1])))};
                *(u32x2*)(dst + 32 + d) = (u32x2){pk2(o1[4 * g] * inv * silu(bflo(g1[0])), o1[4 * g + 1] * inv * silu(bfhi(g1[0]))),
                                                  pk2(o1[4 * g + 2] * inv * silu(bflo(g1[1])), o1[4 * g + 3] * inv * silu(bfhi(g1[1])))};
            }
        }
    }
}

DI void phase_merge(const Params& p, int l, LAS char* lds) {
    const int tidx = otid();
    const bf16_t* h = (const bf16_t*)(p.ws + OFF_H);
    const bf16_t* u = (const bf16_t*)(p.ws + OFF_U);
    const bf16_t* W = (const bf16_t*)(p.ws + OFF_W) + (size_t)l * W_LAYER;
    bf16_t* m = (bf16_t*)(p.ws + OFF_ZM);
    const float* gb = p.gate_bias + l * 4096;
    const int lane = tidx & 63, w = tidx >> 6, wm = w >> 1, wn = w & 1, fr = lane & 15, fq = lane >> 4;
    unsigned* stash = (unsigned*)(p.ws + OFF_ZC) + tidx;
    const int G = gridDim.x, NT = 257 * 8, vb = vblock();
    const int ntl = (vb < NT) ? (NT - vb + G - 1) / G : 0;
    const int nops = 8 * ntl;
    auto op_of = [&](int f) {
        if (f < 4 * ntl) {
            const int br = f / ntl, i = vb + (f - br * ntl) * G, mt = i >> 3, nt = i & 7;
            return GOp{h + (size_t)mt * 128 * 1024, W + W_IN + (size_t)(3328 + br * 1024 + nt * 128) * 1024, 1024, 1024, 1024, 2 * (mt + nt)};
        }
        const int f2 = f - 4 * ntl, k = f2 >> 2, br = f2 & 3, i = vb + k * G, mt = i >> 3, nt = i & 7;
        const int koff = (br == 0) ? 0 : (br == 1) ? 256 : (br == 2) ? 768 : 1024;
        const int kk = (br == 1) ? 512 : 256;
        const size_t woff = (br == 0) ? W_OP : (br == 1) ? W_OM : (br == 2) ? W_OC : W_OS;
        return GOp{u + (size_t)mt * 128 * 1280 + koff, W + woff + (size_t)nt * 128 * kk, 1280, kk, kk, mt + nt};
    };
    f32x4 acc[4][4];
    bool inflight = false;
    unsigned sq[4][4], sqn[4][4];
#pragma unroll
    for (int mi = 0; mi < 4; ++mi)
#pragma unroll
        for (int ni = 0; ni < 4; ++ni) { sq[mi][ni] = 0x01010101u; sqn[mi][ni] = 0x01010101u; }
    for (int f = 0; f < nops; ++f) {
        const bool gate = f < 4 * ntl;
        int br, i;
        if (gate) { br = f / ntl; i = vb + (f - br * ntl) * G; } else { const int f2 = f - 4 * ntl; br = f2 & 3; i = vb + (f2 >> 2) * G; }
        const int mt = i >> 3, nt = i & 7;
        const bool has_next = f + 1 < nops;
        const GOp g = op_of(f), gn = op_of(has_next ? f + 1 : f);
        unsigned* st = stash + (size_t)(i * 4 + br) * 4096;
        if (gate || br == 0) zero_acc(acc);
        if (!gate) {
#pragma unroll
            for (int mi = 0; mi < 4; ++mi)
#pragma unroll
                for (int ni = 0; ni < 4; ++ni) sq[mi][ni] = sqn[mi][ni];
            if (br > 0) {
#pragma unroll
                for (int mi = 0; mi < 4; ++mi)
#pragma unroll
                    for (int ni = 0; ni < 4; ++ni) {
                        const unsigned q = sq[mi][ni];
                        acc[mi][ni][0] *= 255.f * __builtin_amdgcn_rcpf((float)(q & 0xffu)); acc[mi][ni][1] *= 255.f * __builtin_amdgcn_rcpf((float)((q >> 8) & 0xffu));
                        acc[mi][ni][2] *= 255.f * __builtin_amdgcn_rcpf((float)((q >> 16) & 0xffu)); acc[mi][ni][3] *= 255.f * __builtin_amdgcn_rcpf((float)(q >> 24));
                    }
            }
        }
        if (has_next && f + 1 >= 4 * ntl) {
            const int f2 = f + 1 - 4 * ntl;
            const unsigned* stn = stash + (size_t)((vb + (f2 >> 2) * G) * 4 + (f2 & 3)) * 4096;
#pragma unroll
            for (int mi = 0; mi < 4; ++mi)
#pragma unroll
                for (int ni = 0; ni < 4; ++ni) sqn[mi][ni] = stn[(mi * 4 + ni) * 256];
        }
        f32x4 bvv[4];
        if (gate) {
#pragma unroll
            for (int ni = 0; ni < 4; ++ni) bvv[ni] = *(const f32x4*)(gb + br * 1024 + nt * 128 + wn * 64 + ni * 16 + fq * 4);
        }
        gemm_core(acc, g, lds, tidx, inflight, has_next, gn);
        inflight = has_next;
        if (gate) {
#pragma unroll
            for (int ni = 0; ni < 4; ++ni) {
                const f32x4 bv = bvv[ni];
#pragma unroll
                for (int mi = 0; mi < 4; ++mi) {
                    const f32x4 a = acc[mi][ni] + bv;
                    const unsigned q0 = (unsigned)(fmaxf(sigm(a[0]) * 255.f, 1.f) + 0.5f), q1 = (unsigned)(fmaxf(sigm(a[1]) * 255.f, 1.f) + 0.5f);
                    const unsigned q2 = (unsigned)(fmaxf(sigm(a[2]) * 255.f, 1.f) + 0.5f), q3 = (unsigned)(fmaxf(sigm(a[3]) * 255.f, 1.f) + 0.5f);
                    st[(mi * 4 + ni) * 256] = q0 | (q1 << 8) | (q2 << 16) | (q3 << 24);
                }
            }
        } else {
            const float c = 1.f / 255.f;
#pragma unroll
            for (int mi = 0; mi < 4; ++mi)
#pragma unroll
                for (int ni = 0; ni < 4; ++ni) {
                    const unsigned q = sq[mi][ni];
                    acc[mi][ni][0] *= c * (float)(q & 0xffu); acc[mi][ni][1] *= c * (float)((q >> 8) & 0xffu);
                    acc[mi][ni][2] *= c * (float)((q >> 16) & 0xffu); acc[mi][ni][3] *= c * (float)(q >> 24);
                }
            if (br == 3) {
#pragma unroll
                for (int mi = 0; mi < 4; ++mi) {
                    const int row = mt * 128 + wm * 64 + mi * 16 + fr;
                    store_row_wide(m + (size_t)row * 1024 + nt * 128 + wn * 64, acc[mi], fq);
                }
            }
        }
    }
}

DI void phase_wo(const Params& p, int l, LAS char* lds) {
    const int tidx = otid();
    const bf16_t* m = (const bf16_t*)(p.ws + OFF_ZM);
    const bf16_t* W = (const bf16_t*)(p.ws + OFF_W) + (size_t)l * W_LAYER + W_O;
    bf16_t* o = (bf16_t*)(p.ws + OFF_H);
    const int lane = tidx & 63, w = tidx >> 6, wm = w >> 1, wn = w & 1, fr = lane & 15, fq = lane >> 4;
    auto op_of = [&](int i) { const int mt = i >> 3, nt = i & 7; return GOp{m + (size_t)mt * 128 * 1024, W + (size_t)nt * 128 * 1024, 1024, 1024, 1024, 2 * (mt + nt)}; };
    bool inflight = false;
    for (int i = vblock(); i < 257 * 8; i += gridDim.x) {
        const int mt = i >> 3, nt = i & 7;
        const bool has_next = i + (int)gridDim.x < 257 * 8;
        const GOp g = op_of(i), gn = op_of(has_next ? i + (int)gridDim.x : i);
        f32x4 acc[4][4]; zero_acc(acc);
        gemm_core<true>(acc, g, lds, tidx, inflight, has_next, gn, true);
        inflight = has_next;
#pragma unroll
        for (int mi = 0; mi < 4; ++mi) {
            const int row = mt * 128 + wm * 64 + mi * 16 + fr;
            store_row_wide(o + (size_t)row * 1024 + nt * 128 + wn * 64, acc[mi], fq);
        }
    }
}


#define XB_TMO      128
#define XB_XCNT(j)  (256  + 64 * (j))
#define XB_XSUB(j)  (1280 + 64 * (j))
#define XB_XGEN(j)  (2304 + 64 * (j))
#define XB_TOP      3328
#define XB_TOPGEN   3392
#define XCD_BAR_WORDS 3456
#define XB_SPIN_CAP (1u << 22)
DI unsigned xb_ld(unsigned* p) { return __hip_atomic_load(p, __ATOMIC_RELAXED, __HIP_MEMORY_SCOPE_AGENT); }
DI unsigned xb_add(unsigned* p, unsigned v) { return __hip_atomic_fetch_add(p, v, __ATOMIC_RELAXED, __HIP_MEMORY_SCOPE_AGENT); }
DI unsigned xb_xcc_id() { return (unsigned)__builtin_amdgcn_s_getreg((3 << 11) | 20) & 0xFu; }
#define XB_SPIN(cond, bar) do { unsigned _sp = 0; while (cond) { __builtin_amdgcn_s_sleep(1); \
    if ((++_sp & 255u) == 0u) { if (xb_ld(&(bar)[XB_TMO])) break; if (_sp > XB_SPIN_CAP) { atomicAdd(&(bar)[XB_TMO], 1u); break; } } } } while (0)
struct XcdBarrier { unsigned* bar; unsigned x; unsigned nloc, nx; };
DI XcdBarrier xcd_barrier_post(unsigned* bar) {
    XcdBarrier b; b.bar = bar; b.x = xb_xcc_id(); b.nloc = 0u; b.nx = 0u;
    if (threadIdx.x == 0) (void)xb_add(&bar[XB_XCNT(b.x)], 1u);
    return b;
}
DI void xcd_barrier_complete(unsigned* bar, unsigned x, unsigned& nloc, unsigned& nx) {
    const unsigned G = gridDim.x * gridDim.y * gridDim.z;
    unsigned sum, cnt, mine, sp = 0u;
    for (;;) {
        sum = 0u; cnt = 0u; mine = 0u;
#pragma unroll
        for (unsigned j = 0; j < 16; ++j) { const unsigned c = xb_ld(&bar[XB_XCNT(j)]); sum += c; cnt += (c > 0u) ? 1u : 0u; mine = (j == x) ? c : mine; }
        if (sum == G) break;
        __builtin_amdgcn_s_sleep(1);
        if ((++sp & 255u) == 0u) { if (xb_ld(&bar[XB_TMO])) break; if (sp > XB_SPIN_CAP) { atomicAdd(&bar[XB_TMO], 1u); break; } }
    }
    nloc = mine > 0u ? mine : 1u; nx = cnt > 0u ? cnt : 1u;
}
DI void xcd_barrier(XcdBarrier& b) {
    asm volatile("s_waitcnt vmcnt(0)" ::: "memory");
    __syncthreads();
    if (threadIdx.x == 0) {
        unsigned* bar = b.bar;
        __builtin_amdgcn_s_waitcnt(0);
        if (b.nloc == 0u) xcd_barrier_complete(bar, b.x, b.nloc, b.nx);
        const unsigned nloc = b.nloc, nx = b.nx;
        const unsigned old = xb_add(&bar[XB_XSUB(b.x)], 1u);
        const unsigned gen = old / nloc;
        if (old + 1u == (gen + 1u) * nloc) {
            __builtin_amdgcn_fence(__ATOMIC_RELEASE, "agent");
            asm volatile("s_waitcnt vmcnt(0)" ::: "memory");
            const unsigned og = xb_add(&bar[XB_TOP], 1u);
            const unsigned tg = og / nx;
            if (og + 1u == (tg + 1u) * nx) xb_add(&bar[XB_TOPGEN], 1u);
            else XB_SPIN(xb_ld(&bar[XB_TOPGEN]) == tg, bar);
            __builtin_amdgcn_fence(__ATOMIC_ACQUIRE, "agent");
            xb_add(&bar[XB_XGEN(b.x)], 1u);
            asm volatile("s_waitcnt vmcnt(0)" ::: "memory");
        } else {
            XB_SPIN(xb_ld(&bar[XB_XGEN(b.x)]) == gen, bar);
            __builtin_amdgcn_fence(__ATOMIC_ACQUIRE, "agent");
            asm volatile("s_waitcnt vmcnt(0)" ::: "memory");
        }
    }
    __syncthreads();
}

constexpr int NPHASE = 1 + 7 * NLAYER;
__global__ void __launch_bounds__(256, 2) mega(Params p) {
    __shared__ __attribute__((aligned(16))) char smem[65536];
    LAS char* lds = (LAS char*)smem;
    cg::grid_group grid = cg::this_grid();
    XcdBarrier xb = xcd_barrier_post((unsigned*)(p.ws + OFF_BAR));
    for (int ph = p.phase_lo; ph <= p.phase_hi; ++ph) {
        if (ph == 0) phase_init(p, lds);
        else {
            const int l = (ph - 1) / 7, s = (ph - 1) % 7;
            switch (s) {
                case 0: for (int r = 0; r < REP_IN; ++r) phase_gemm_in(p, l, lds); break;
                case 1: for (int r = 0; r < REP_MIX; ++r) phase_mixers(p, l, lds); break;
                case 2: for (int r = 0; r < REP_QKV; ++r) phase_qkv(p, l, lds); break;
                case 3: for (int r = 0; r < REP_ATTN; ++r) phase_attn(p, l, lds); break;
                case 4: for (int r = 0; r < REP_MERGE; ++r) phase_merge(p, l, lds); break;
                case 5: for (int r = 0; r < REP_WO; ++r) phase_wo(p, l, lds); break;
                default: phase_norm(p, l, 1); break;
            }
        }
        if (ph < p.phase_hi) { if (p.phase_lo < 0) grid.sync(); else xcd_barrier(xb); }
    }
}

extern "C" void kernel_launch(void* const* d_in, const int* in_sizes, int n_in, void* d_out, int out_size, void* d_ws, size_t ws_size, hipStream_t stream) {
    static int grid_blocks = 0;
    if (!grid_blocks) {
        int dev = 0, cus = 0, per_cu = 0;
        hipGetDevice(&dev);
        hipDeviceGetAttribute(&cus, hipDeviceAttributeMultiprocessorCount, dev);
        hipOccupancyMaxActiveBlocksPerMultiprocessor(&per_cu, mega, 256, 0);
        if (per_cu > 2) per_cu = 2;
        if (per_cu < 1) per_cu = 1;
        grid_blocks = cus * per_cu;
        if (grid_blocks > 512) grid_blocks = 512;
    }
    Params p{};
    const float** f = (const float**)&p;
    for (int i = 0; i < 22; ++i) f[i] = (const float*)d_in[i];
    p.out = (float*)d_out; p.ws = (char*)d_ws;
    if (ws_size < OFF_END) { fprintf(stderr, "workspace too small: %zu < %zu\n", ws_size, (size_t)OFF_END); return; }
#if MULTI_LAUNCH
    for (int ph = 0; ph < NPHASE; ++ph) {
        p.phase_lo = ph; p.phase_hi = ph;
        hipLaunchKernelGGL(mega, dim3(grid_blocks), dim3(256), 0, stream, p);
    }
#else
    p.phase_lo = 0; p.phase_hi = NPHASE - 1;
    (void)hipMemsetAsync((char*)d_ws + OFF_BAR, 0, 16384, stream);
    void* args[] = {&p};
    hipError_t e = hipLaunchCooperativeKernel((void*)mega, dim3(grid_blocks), dim3(256), args, 0, stream);
    if (e != hipSuccess) fprintf(stderr, "cooperative launch failed: %s (grid %d)\n", hipGetErrorString(e), grid_blocks);
#endif
}
```

```cpp
#include <hip/hip_runtime.h>
#include <hip/hip_cooperative_groups.h>
#include <cstdio>
#include <cstdint>
namespace cg = cooperative_groups;

#ifndef REP_IN
#define REP_IN 1
#endif
#ifndef REP_QKV
#define REP_QKV 1
#endif
#ifndef REP_WO
#define REP_WO 1
#endif
#ifndef REP_ATTN
#define REP_ATTN 1
#endif
#ifndef REP_MIX
#define REP_MIX 1
#endif
#ifndef REP_MERGE
#define REP_MERGE 1
#endif
#ifndef MULTI_LAUNCH
#define MULTI_LAUNCH 0
#endif

#define LAS __attribute__((address_space(3)))
typedef unsigned short bf16_t;
typedef short bf16x8 __attribute__((ext_vector_type(8)));
typedef short s16x4 __attribute__((ext_vector_type(4)));
typedef float f32x2 __attribute__((ext_vector_type(2)));
typedef float f32x4 __attribute__((ext_vector_type(4)));
typedef float f32x16 __attribute__((ext_vector_type(16)));
typedef unsigned u32x2 __attribute__((ext_vector_type(2)));
typedef unsigned u32x4 __attribute__((ext_vector_type(4)));
typedef __bf16 bf2_t __attribute__((ext_vector_type(2)));

constexpr int LSEQ = 4112, MTOK = 32896, LP = 4224, DM = 1024;
constexpr float EPS = 1e-6f;
constexpr int NLAYER = 4;
constexpr size_t W_IN = 0, W_UQ = 7602176, W_UKV = 7798784, W_OP = 7929856, W_OM = 8192000, W_OC = 8716288, W_OS = 8978432, W_O = 9240576, W_LAYER = 10289152;
constexpr size_t OFF_W = 0;
constexpr size_t OFF_H = OFF_W + W_LAYER * 2 * NLAYER;
constexpr size_t OFF_ZC = OFF_H + (size_t)MTOK * 1024 * 2;
constexpr size_t OFF_ZM = OFF_ZC + (size_t)MTOK * 2304 * 2;
constexpr size_t OFF_U = OFF_ZM + (size_t)MTOK * 1024 * 2;
constexpr size_t OFF_META = OFF_U + (size_t)MTOK * 1280 * 2;
constexpr size_t OFF_ROPE = OFF_META + 128 * 1024 * 4;
constexpr size_t OFF_RS = OFF_ROPE + (size_t)LSEQ * 16 * 2 * 4;
constexpr size_t OFF_SCR = OFF_RS + (size_t)MTOK * 2 * 4;
constexpr size_t OFF_BAR = OFF_SCR + (size_t)512 * 131072;
constexpr size_t OFF_END = OFF_BAR + 16384;
constexpr size_t OFF_Q = OFF_ZC;
constexpr size_t OFF_KN = OFF_Q + (size_t)MTOK * 768 * 2;
constexpr size_t OFF_KR = OFF_KN + (size_t)MTOK * 512 * 2;
constexpr size_t OFF_VT = OFF_KR + (size_t)MTOK * 32 * 2;
static_assert(OFF_VT + (size_t)64 * 64 * LP * 2 <= OFF_ZM, "qkv alias overflow");
static_assert((size_t)257 * 8 * 4 * 16384 <= (size_t)MTOK * 2304 * 2, "u8 gate stash (aliases zc) overflow");

struct Params {
    const float* x; const float* meta; const float* pre_g; const float* w_in; const float* gate_bias;
    const float* pool_w; const float* pool_scale; const float* w_out_pool; const float* q_norm_g; const float* w_uq;
    const float* kv_norm_g; const float* w_ukv; const float* w_out_mla; const float* conf_dw_w; const float* conf_dw_b;
    const float* conf_ln_g; const float* conf_ln_b; const float* w_out_conf; const float* sc_dw_w; const float* w_out_sc;
    const float* w_o; const float* post_g;
    float* out; char* ws;
    int phase_lo, phase_hi;
};

#define DI __device__ __forceinline__
DI float bf2f(bf16_t v) { return __uint_as_float(((unsigned)v) << 16); }
DI float bflo(unsigned v) { return __uint_as_float(v << 16); }
DI float bfhi(unsigned v) { return __uint_as_float(v & 0xffff0000u); }
DI unsigned pk2(float lo, float hi) { f32x2 v = {lo, hi}; bf2_t r = __builtin_convertvector(v, bf2_t); return __builtin_bit_cast(unsigned, r); }
DI bf16_t f2bf(float v) { return (bf16_t)(pk2(v, 0.f) & 0xffffu); }
DI float sigm(float x) { return __builtin_amdgcn_rcpf(1.f + __expf(-x)); }
DI float silu(float x) { return x * __builtin_amdgcn_rcpf(1.f + __expf(-x)); }
DI float xadd32(float v) { const auto r = __builtin_amdgcn_permlane32_swap(__float_as_uint(v), __float_as_uint(v), false, false); return __uint_as_float(r[0]) + __uint_as_float(r[1]); }
DI float xadd16(float v) { const auto r = __builtin_amdgcn_permlane16_swap(__float_as_uint(v), __float_as_uint(v), false, false); return __uint_as_float(r[0]) + __uint_as_float(r[1]); }
DI float wave_sum(float v) {
    v = xadd32(v); v = xadd16(v);
#pragma unroll
    for (int o = 8; o; o >>= 1) v += __shfl_xor(v, o);
    return v;
}
DI void gload_lds16(const void* g, LAS char* l) { __builtin_amdgcn_global_load_lds((const unsigned*)g, (LAS unsigned*)l, 16, 0, 0); }
DI int otid() { int t = threadIdx.x; asm volatile("" : "+v"(t)); return t; }
DI int vblock() { const int G = gridDim.x; return (G & 7) ? (int)blockIdx.x : (int)((blockIdx.x & 7) * (G >> 3) + (blockIdx.x >> 3)); }

struct GOp { const bf16_t* A; const bf16_t* Bt; int lda, ldb, K, krot; };
DI void gemm_issue(const GOp& g, int kt, LAS char* stage, int w, int lane) {
    const int nk = g.K >> 6;
    const int kk = ((kt + g.krot) & (nk - 1)) * 64;
    LAS char* base = stage + w * 1024;
#pragma unroll
    for (int j = 0; j < 4; ++j) {
        const int o = (j * 4 + w) * 1024 + lane * 16, row = o >> 7, cs = (o >> 4) & 7, c = cs ^ ((row >> 1) & 7);
        gload_lds16(g.A + kk + (unsigned)(row * g.lda + c * 8), base + j * 4096);
        gload_lds16(g.Bt + kk + (unsigned)(row * g.ldb + c * 8), base + 16384 + j * 4096);
    }
}
template <bool WIDE = false>
DI void gemm_core(f32x4 (&acc)[4][4], const GOp& g, LAS char* lds, const int tidx, const bool have_first, const bool has_next, const GOp& gn, const bool fw16 = false) {
    const int tid = tidx, lane = tid & 63, w = tid >> 6, wm = w >> 1, wn = w & 1;
    unsigned oa[4], ob[4];
#pragma unroll
    for (int j = 0; j < 4; ++j) {
        const int o = (j * 4 + w) * 1024 + lane * 16, row = o >> 7, cs = (o >> 4) & 7, c = cs ^ ((row >> 1) & 7);
        oa[j] = (unsigned)(row * g.lda + c * 8); ob[j] = (unsigned)(row * g.ldb + c * 8);
    }
    const int nk = g.K >> 6;
    const int fr = lane & 15, fq = lane >> 4;
    const int sw = (fq ^ (fr >> 1)) << 4;
    const int aoff = (wm * 64 + fr) * 128, boff = 16384 + (wn * 64 + fr) * 128;
    if (!have_first) gemm_issue(g, 0, lds, w, lane);
    for (int kt = 0; kt < nk; ++kt) {
        if (kt == 0 && have_first && fw16) {
            asm volatile("s_waitcnt vmcnt(8) lgkmcnt(0)" ::: "memory");
            __builtin_amdgcn_s_barrier();
            asm volatile("" ::: "memory");
        } else {
            asm volatile("s_waitcnt vmcnt(0)" ::: "memory");
            __syncthreads();
        }
        if (kt + 1 < nk) {
            LAS char* base = lds + ((kt + 1) & 1) * 32768 + w * 1024;
            const int kn = ((kt + 1 + g.krot) & (nk - 1)) * 64;
            const bf16_t* Ak = g.A + kn; const bf16_t* Bk = g.Bt + kn;
#pragma unroll
            for (int j = 0; j < 4; ++j) { gload_lds16(Ak + oa[j], base + j * 4096); gload_lds16(Bk + ob[j], base + 16384 + j * 4096); }
        } else if (has_next) gemm_issue(gn, 0, lds, w, lane);
        LAS char* st = lds + (kt & 1) * 32768;
        if constexpr (WIDE) {
        bf16x8 af[2][4], bfr[2][4];
#pragma unroll
        for (int ks = 0; ks < 2; ++ks) {
#pragma unroll
            for (int i = 0; i < 4; ++i) af[ks][i] = *(LAS bf16x8*)(st + aoff + i * 2048 + (sw ^ (ks * 64)));
#pragma unroll
            for (int i = 0; i < 4; ++i) bfr[ks][i] = *(LAS bf16x8*)(st + boff + i * 2048 + (sw ^ (ks * 64)));
        }
        __builtin_amdgcn_sched_barrier(0);
        __builtin_amdgcn_s_setprio(1);
#pragma unroll
        for (int ks = 0; ks < 2; ++ks)
#pragma unroll
            for (int mi = 0; mi < 4; ++mi)
#pragma unroll
                for (int ni = 0; ni < 4; ++ni) acc[mi][ni] = __builtin_amdgcn_mfma_f32_16x16x32_bf16(bfr[ks][ni], af[ks][mi], acc[mi][ni], 0, 0, 0);
        __builtin_amdgcn_s_setprio(0);
        } else {
#pragma unroll
        for (int ks = 0; ks < 2; ++ks) {
            bf16x8 af[4], bfr[4];
#pragma unroll
            for (int i = 0; i < 4; ++i) af[i] = *(LAS bf16x8*)(st + aoff + i * 2048 + (sw ^ (ks * 64)));
#pragma unroll
            for (int i = 0; i < 4; ++i) bfr[i] = *(LAS bf16x8*)(st + boff + i * 2048 + (sw ^ (ks * 64)));
            __builtin_amdgcn_s_setprio(1);
#pragma unroll
            for (int mi = 0; mi < 4; ++mi)
#pragma unroll
                for (int ni = 0; ni < 4; ++ni) acc[mi][ni] = __builtin_amdgcn_mfma_f32_16x16x32_bf16(bfr[ni], af[mi], acc[mi][ni], 0, 0, 0);
            __builtin_amdgcn_s_setprio(0);
        }
        }
    }
    if (!has_next) __syncthreads();
}
DI void gemm_core(f32x4 (&acc)[4][4], const bf16_t* A, int lda, const bf16_t* Bt, int ldb, int K, LAS char* lds, const int tidx, const int krot = 0) {
    const GOp g{A, Bt, lda, ldb, K, krot};
    gemm_core<false>(acc, g, lds, tidx, false, false, g);
}
DI void store_row_wide(bf16_t* rowbase, const f32x4 (&a)[4], const int fq) {
#pragma unroll
    for (int pr = 0; pr < 2; ++pr) {
        const unsigned x0 = pk2(a[2 * pr][0], a[2 * pr][1]), x1 = pk2(a[2 * pr][2], a[2 * pr][3]);
        const unsigned y0 = pk2(a[2 * pr + 1][0], a[2 * pr + 1][1]), y1 = pk2(a[2 * pr + 1][2], a[2 * pr + 1][3]);
        const auto r0 = __builtin_amdgcn_permlane16_swap(x0, y0, false, false);
        const auto r1 = __builtin_amdgcn_permlane16_swap(x1, y1, false, false);
        *(u32x4*)(rowbase + pr * 32 + (fq & 1) * 16 + (fq >> 1) * 8) = (u32x4){r0[0], r1[0], r0[1], r1[1]};
    }
}
DI void zero_acc(f32x4 (&acc)[4][4]) {
#pragma unroll
    for (int i = 0; i < 4; ++i)
#pragma unroll
        for (int j = 0; j < 4; ++j) acc[i][j] = (f32x4){0.f, 0.f, 0.f, 0.f};
}

DI const float* res_src(const Params& p, int row, bool from_input) {
    const int b = row / LSEQ, t = row - b * LSEQ;
    if (t < 16) return from_input ? p.meta + t * 1024 : (const float*)(p.ws + OFF_META) + (b * 16 + t) * 1024;
    return (from_input ? p.x : (const float*)p.out) + ((size_t)b * 4096 + (t - 16)) * 1024;
}
DI float* res_dst(const Params& p, int row) {
    const int b = row / LSEQ, t = row - b * LSEQ;
    if (t < 16) return (float*)(p.ws + OFF_META) + (b * 16 + t) * 1024;
    return p.out + ((size_t)b * 4096 + (t - 16)) * 1024;
}

DI void phase_norm(const Params& p, int l, int mode) {
    const int tidx = otid();
    const int lane = tidx & 63, w = tidx >> 6;
    bf16_t* h = (bf16_t*)(p.ws + OFF_H);
    const bool from_input = (mode == 0) || (l == 0);
    const bool do_h = (mode == 0) || (l < NLAYER - 1);
    const float* gpost = p.post_g + l * 1024;
    const float* gpre = p.pre_g + (mode == 0 ? 0 : (l + 1 < NLAYER ? l + 1 : 0)) * 1024;
    const int c0 = lane * 8;
    float gp[16], gq[16];
#pragma unroll
    for (int i = 0; i < 16; ++i) { const int c = (i < 8) ? c0 + i : 512 + c0 + (i - 8); gp[i] = gpost[c]; gq[i] = gpre[c]; }
    const int stride = gridDim.x * 4;
    int row = blockIdx.x * 4 + w;
    f32x4 a0, a1, a2, a3; u32x4 o0 = {0u, 0u, 0u, 0u}, o1 = {0u, 0u, 0u, 0u};
    auto load_row = [&](int r, f32x4& b0, f32x4& b1, f32x4& b2, f32x4& b3, u32x4& q0, u32x4& q1) {
        const float* src = res_src(p, r, from_input);
        b0 = *(const f32x4*)(src + c0); b1 = *(const f32x4*)(src + c0 + 4); b2 = *(const f32x4*)(src + 512 + c0); b3 = *(const f32x4*)(src + 512 + c0 + 4);
        if (mode == 1) { const bf16_t* orow = h + (size_t)r * 1024; q0 = *(const u32x4*)(orow + c0); q1 = *(const u32x4*)(orow + 512 + c0); }
    };
    if (row < MTOK) load_row(row, a0, a1, a2, a3, o0, o1);
    while (row < MTOK) {
        const int nrow = row + stride;
        f32x4 n0 = a0, n1 = a1, n2 = a2, n3 = a3; u32x4 m0 = o0, m1 = o1;
        if (nrow < MTOK) load_row(nrow, n0, n1, n2, n3, m0, m1);
        float v[16];
#pragma unroll
        for (int i = 0; i < 4; ++i) { v[i] = a0[i]; v[4 + i] = a1[i]; v[8 + i] = a2[i]; v[12 + i] = a3[i]; }
        if (mode == 1) {
            float ov[16];
#pragma unroll
            for (int i = 0; i < 4; ++i) { ov[2 * i] = bflo(o0[i]); ov[2 * i + 1] = bfhi(o0[i]); ov[8 + 2 * i] = bflo(o1[i]); ov[8 + 2 * i + 1] = bfhi(o1[i]); }
            float ss = 0.f;
#pragma unroll
            for (int i = 0; i < 16; ++i) ss += ov[i] * ov[i];
            ss = wave_sum(ss);
            const float rstd = rsqrtf(ss * (1.f / 1024.f) + EPS);
#pragma unroll
            for (int i = 0; i < 16; ++i) v[i] += ov[i] * rstd * gp[i];
            float* dst = res_dst(p, row);
            *(f32x4*)(dst + c0) = (f32x4){v[0], v[1], v[2], v[3]}; *(f32x4*)(dst + c0 + 4) = (f32x4){v[4], v[5], v[6], v[7]};
            *(f32x4*)(dst + 512 + c0) = (f32x4){v[8], v[9], v[10], v[11]}; *(f32x4*)(dst + 512 + c0 + 4) = (f32x4){v[12], v[13], v[14], v[15]};
        }
        if (do_h) {
            float ss = 0.f;
#pragma unroll
            for (int i = 0; i < 16; ++i) ss += v[i] * v[i];
            ss = wave_sum(ss);
            const float rstd = rsqrtf(ss * (1.f / 1024.f) + EPS);
            float hv[16];
#pragma unroll
            for (int i = 0; i < 16; ++i) hv[i] = v[i] * rstd * gq[i];
            bf16_t* hrow = h + (size_t)row * 1024;
            *(u32x4*)(hrow + c0) = (u32x4){pk2(hv[0], hv[1]), pk2(hv[2], hv[3]), pk2(hv[4], hv[5]), pk2(hv[6], hv[7])};
            *(u32x4*)(hrow + 512 + c0) = (u32x4){pk2(hv[8], hv[9]), pk2(hv[10], hv[11]), pk2(hv[12], hv[13]), pk2(hv[14], hv[15])};
        }
        a0 = n0; a1 = n1; a2 = n2; a3 = n3; o0 = m0; o1 = m1; row = nrow;
    }
}

DI void convT_tile(const float* __restrict__ src, int ldsrc, bf16_t* __restrict__ dst, int K, int tk, int tn, int mode, const float* __restrict__ rowscale, float scale, LAS float* lds, const int tidx) {
    const int t = tidx, nl = t & 63, kq = t >> 6;
    const int np = tn * 64 + nl;
    int col = np;
    if (mode == 1) col = (np < 512) ? np : (np < 2304) ? np + 928 : (np < 3232) ? np - 1792 : (np < 3328) ? -1 : np - 96;
#pragma unroll
    for (int i = 0; i < 16; ++i) {
        const int kl = i * 4 + kq, k = tk * 64 + kl;
        float v = 0.f;
        if (col >= 0) v = src[(size_t)k * ldsrc + col];
        v *= scale;
        if (rowscale) v *= rowscale[k];
        lds[kl * 65 + nl] = v;
    }
    __syncthreads();
#pragma unroll 4
    for (int i = 0; i < 8; ++i) {
        const int nl2 = i * 8 + (t >> 5), kl2 = (t & 31) * 2;
        const unsigned pk = pk2(lds[kl2 * 65 + nl2], lds[(kl2 + 1) * 65 + nl2]);
        *(unsigned*)(dst + (size_t)(tn * 64 + nl2) * K + tk * 64 + kl2) = pk;
    }
    __syncthreads();
}

struct CTile { const float* src; const float* rowscale; bf16_t* dst; int ld, K, tk, tn, mode; float scale; };
DI CTile ct_decode(const Params& p, int i) {
    constexpr int TPL = 2512;
    const int l = i / TPL; int r = i - l * TPL;
    bf16_t* W = (bf16_t*)(p.ws + OFF_W) + (size_t)l * W_LAYER;
    if (r < 1856) return CTile{p.w_in + (size_t)l * 1024 * 7328, nullptr, W + W_IN, 7328, 1024, r & 15, r >> 4, 1, 1.f};
    r -= 1856;
    if (r < 48) return CTile{p.w_uq + (size_t)l * 256 * 768, p.q_norm_g + l * 256, W + W_UQ, 768, 256, r & 3, r >> 2, 0, 0.10206207261596577f * 1.4426950408889634f};
    r -= 48;
    if (r < 32) return CTile{p.w_ukv + (size_t)l * 128 * 1024, p.kv_norm_g + l * 128, W + W_UKV, 1024, 128, r & 1, r >> 1, 0, 1.f};
    r -= 32;
    if (r < 64) return CTile{p.w_out_pool + (size_t)l * 256 * 1024, nullptr, W + W_OP, 1024, 256, r & 3, r >> 2, 0, 1.f};
    r -= 64;
    if (r < 128) return CTile{p.w_out_mla + (size_t)l * 512 * 1024, nullptr, W + W_OM, 1024, 512, r & 7, r >> 3, 0, 1.f};
    r -= 128;
    if (r < 64) return CTile{p.w_out_conf + (size_t)l * 256 * 1024, nullptr, W + W_OC, 1024, 256, r & 3, r >> 2, 0, 1.f};
    r -= 64;
    if (r < 64) return CTile{p.w_out_sc + (size_t)l * 256 * 1024, nullptr, W + W_OS, 1024, 256, r & 3, r >> 2, 0, 1.f};
    r -= 64;
    return CTile{p.w_o + (size_t)l * 1024 * 1024, nullptr, W + W_O, 1024, 1024, r & 15, r >> 4, 0, 1.f};
}
DI void ct_load(const CTile& c, float (&v)[16], const int tidx) {
    const int nl = tidx & 63, kq = tidx >> 6, np = c.tn * 64 + nl;
    int col = np;
    if (c.mode == 1) col = (np < 512) ? np : (np < 2304) ? np + 928 : (np < 3232) ? np - 1792 : (np < 3328) ? -1 : np - 96;
#pragma unroll
    for (int i = 0; i < 16; ++i) {
        const int k = c.tk * 64 + i * 4 + kq;
        float x = 0.f;
        if (col >= 0) x = c.src[(size_t)k * c.ld + col];
        if (c.rowscale) x *= c.rowscale[k];
        v[i] = x;
    }
}
DI void ct_finish(const CTile& c, const float (&v)[16], LAS float* lds, const int tidx) {
    const int t = tidx, nl = t & 63, kq = t >> 6;
#pragma unroll
    for (int i = 0; i < 16; ++i) lds[(i * 4 + kq) * 65 + nl] = v[i] * c.scale;
    __syncthreads();
#pragma unroll
    for (int i = 0; i < 8; ++i) {
        const int nl2 = i * 8 + (t >> 5), kl2 = (t & 31) * 2;
        *(unsigned*)(c.dst + (size_t)(c.tn * 64 + nl2) * c.K + c.tk * 64 + kl2) = pk2(lds[kl2 * 65 + nl2], lds[(kl2 + 1) * 65 + nl2]);
    }
    __syncthreads();
}

DI void phase_init(const Params& p, LAS char* lds) {
    const int tidx = otid();
    {
        constexpr int NTL = 2512 * NLAYER;
        int i = blockIdx.x;
        float v[16], vn[16];
        CTile c = ct_decode(p, i < NTL ? i : 0);
        if (i < NTL) ct_load(c, v, tidx);
        while (i < NTL) {
            const int in = i + gridDim.x;
            const CTile cn = ct_decode(p, in < NTL ? in : i);
            if (in < NTL) ct_load(cn, vn, tidx);
            ct_finish(c, v, (LAS float*)lds, tidx);
#pragma unroll
            for (int j = 0; j < 16; ++j) v[j] = vn[j];
            c = cn; i = in;
        }
    }
    float* rope = (float*)(p.ws + OFF_ROPE);
    for (int i = blockIdx.x * 256 + tidx; i < LSEQ * 16; i += gridDim.x * 256) {
        const int pos = i >> 4, j = i & 15;
        const float inv = exp2f(-(float)j * 0.8304820237218406f);
        double rev = (double)pos * (double)inv * 0.15915494309189535;
        rev -= floor(rev);
        const float rf = (float)rev;
        rope[2 * i] = __builtin_amdgcn_cosf(rf); rope[2 * i + 1] = __builtin_amdgcn_sinf(rf);
    }
    phase_norm(p, 0, 0);
}

DI void phase_gemm_in(const Params& p, int l, LAS char* lds) {
    const int tidx = otid();
    const bf16_t* h = (const bf16_t*)(p.ws + OFF_H);
    const bf16_t* W = (const bf16_t*)(p.ws + OFF_W) + (size_t)l * W_LAYER + W_IN;
    bf16_t* zc = (bf16_t*)(p.ws + OFF_ZC); bf16_t* zm = (bf16_t*)(p.ws + OFF_ZM);
    const int lane = tidx & 63, w = tidx >> 6, wm = w >> 1, wn = w & 1, fr = lane & 15, fq = lane >> 4;
    auto tile_of = [&](int i, int& mt, int& nt) {
        if (i < 3 * 2056) { const int ng = i / 2056, r = i - ng * 2056; mt = r >> 3; nt = ng * 8 + (r & 7); }
        else { const int r = i - 3 * 2056; mt = r >> 1; nt = 24 + (r & 1); }
    };
    auto op_of = [&](int i) { int mt, nt; tile_of(i, mt, nt); return GOp{h + (size_t)mt * 128 * 1024, W + (size_t)nt * 128 * 1024, 1024, 1024, 1024, 2 * (mt + nt)}; };
    bool inflight = false;
    for (int i = vblock(); i < 257 * 26; i += gridDim.x) {
        int mt, nt; tile_of(i, mt, nt);
        const bool has_next = i + (int)gridDim.x < 257 * 26;
        const GOp g = op_of(i), gn = op_of(has_next ? i + (int)gridDim.x : i);
        f32x4 acc[4][4]; zero_acc(acc);
        gemm_core<true>(acc, g, lds, tidx, inflight, has_next, gn, true);
        inflight = has_next;
#pragma unroll
        for (int mi = 0; mi < 4; ++mi) {
            const int row = mt * 128 + wm * 64 + mi * 16 + fr;
            const int col0 = nt * 128 + wn * 64;
            store_row_wide((nt < 18) ? zc + (size_t)row * 2304 + col0 : zm + (size_t)row * 1024 + (col0 - 2304), acc[mi], fq);
        }
    }
}

DI void phase_mixers(const Params& p, int l, LAS char* lds) {
    const int tidx = otid();
    {
        const bf16_t* zmr = (const bf16_t*)(p.ws + OFF_ZM);
        float* rsb = (float*)(p.ws + OFF_RS);
        const int ln = tidx & 63, wv = tidx >> 6;
        for (int row = blockIdx.x * 4 + wv; row < MTOK; row += gridDim.x * 4) {
            const u32x2 a = *(const u32x2*)(zmr + (size_t)row * 1024 + ln * 4);
            const unsigned b = *(const unsigned*)(zmr + (size_t)row * 1024 + 256 + ln * 2);
            float sq = bflo(a[0]) * bflo(a[0]) + bfhi(a[0]) * bfhi(a[0]) + bflo(a[1]) * bflo(a[1]) + bfhi(a[1]) * bfhi(a[1]);
            float sk = bflo(b) * bflo(b) + bfhi(b) * bfhi(b);
            sq = wave_sum(sq); sk = wave_sum(sk);
            if (ln == 0) *(f32x2*)(rsb + (size_t)row * 2) = (f32x2){rsqrtf(sq * (1.f / 256.f) + EPS), rsqrtf(sk * (1.f / 128.f) + EPS)};
        }
    }
    LAS float* ybuf = (LAS float*)lds;
    const bf16_t* zc = (const bf16_t*)(p.ws + OFF_ZC);
    bf16_t* u = (bf16_t*)(p.ws + OFF_U);
    const int c = tidx, w = c >> 6, lane = c & 63;
    const float* scw = p.sc_dw_w + l * 3 * 256;
    const float* cw = p.conf_dw_w + l * 31 * 256;
    for (int tile = vblock(); tile < 8 * 129; tile += gridDim.x) {
        const int b = tile / 129, t0 = (tile - b * 129) * 32;
        const bf16_t* zb = zc + (size_t)b * LSEQ * 2304;
        bf16_t* ub = u + (size_t)b * LSEQ * 1280;
        {
            asm volatile("" ::: "memory");
            const int c8 = (c & 31) * 8, tb = t0 + (c >> 5) * 4;
            float w0[8], w1[8], w2[8];
            {
                const f32x4 a0 = *(const f32x4*)(scw + c8), a1 = *(const f32x4*)(scw + c8 + 4), b0 = *(const f32x4*)(scw + 256 + c8), b1 = *(const f32x4*)(scw + 256 + c8 + 4);
                const f32x4 d0 = *(const f32x4*)(scw + 512 + c8), d1 = *(const f32x4*)(scw + 512 + c8 + 4);
#pragma unroll
                for (int e = 0; e < 4; ++e) { w0[e] = a0[e]; w0[4 + e] = a1[e]; w1[e] = b0[e]; w1[4 + e] = b1[e]; w2[e] = d0[e]; w2[4 + e] = d1[e]; }
            }
            u32x4 cgr[6], xvr[6], bgr[4], sgr[4];
#pragma unroll
            for (int i = 0; i < 6; ++i) {
                const int t = tb - 2 + i;
                cgr[i] = (u32x4){0u, 0u, 0u, 0u}; xvr[i] = (u32x4){0u, 0u, 0u, 0u};
                if (t >= 0 && t < LSEQ) { const bf16_t* r = zb + (size_t)t * 2304; cgr[i] = *(const u32x4*)(r + 1536 + c8); xvr[i] = *(const u32x4*)(r + 1792 + c8); }
            }
#pragma unroll
            for (int i = 0; i < 4; ++i) {
                const int t = tb + i, tc = (t < LSEQ) ? t : LSEQ - 1;
                const bf16_t* r = zb + (size_t)tc * 2304;
                bgr[i] = *(const u32x4*)(r + 1280 + c8); sgr[i] = *(const u32x4*)(r + 2048 + c8);
            }
            float pr[6][8];
#pragma unroll
            for (int i = 0; i < 6; ++i)
#pragma unroll
                for (int e = 0; e < 4; ++e) { pr[i][2 * e] = bflo(cgr[i][e]) * bflo(xvr[i][e]); pr[i][2 * e + 1] = bfhi(cgr[i][e]) * bfhi(xvr[i][e]); }
#pragma unroll
            for (int j = 0; j < 4; ++j) {
                const int t = tb + j;
                float o[8];
#pragma unroll
                for (int e = 0; e < 8; ++e) {
                    const float bg = (e & 1) ? bfhi(bgr[j][e >> 1]) : bflo(bgr[j][e >> 1]), sg = (e & 1) ? bfhi(sgr[j][e >> 1]) : bflo(sgr[j][e >> 1]);
                    o[e] = bg * (w0[e] * pr[j][e] + w1[e] * pr[j + 1][e] + w2[e] * pr[j + 2][e]) * silu(sg);
                }
                if (t < LSEQ) *(u32x4*)(ub + (size_t)t * 1280 + 1024 + c8) = (u32x4){pk2(o[0], o[1]), pk2(o[2], o[3]), pk2(o[4], o[5]), pk2(o[6], o[7])};
            }
        }
    }
    for (int tile = vblock(); tile < 8 * 129; tile += gridDim.x) {
        const int b = tile / 129, t0 = (tile - b * 129) * 32;
        const bf16_t* zb = zc + (size_t)b * LSEQ * 2304;
        bf16_t* ub = u + (size_t)b * LSEQ * 1280;
        {
            asm volatile("" ::: "memory");
            LAS bf16_t* gl = (LAS bf16_t*)(lds + 32768);
            {
                u32x4 av[8], gv[8];
#pragma unroll
                for (int it = 0; it < 8; ++it) {
                    const int q = c + 256 * it, r = q >> 5, c8 = (q & 31) * 8, t = t0 - 30 + r;
                    av[it] = (u32x4){0u, 0u, 0u, 0u}; gv[it] = (u32x4){0u, 0u, 0u, 0u};
                    if (q < 62 * 32 && t >= 0 && t < LSEQ) { const bf16_t* rp = zb + (size_t)t * 2304; av[it] = *(const u32x4*)(rp + 512 + c8); gv[it] = *(const u32x4*)(rp + 768 + c8); }
                }
#pragma unroll
                for (int it = 0; it < 8; ++it) {
                    const int q = c + 256 * it, r = q >> 5, c8 = (q & 31) * 8;
                    u32x4 o;
#pragma unroll
                    for (int e = 0; e < 4; ++e) o[e] = pk2(bflo(av[it][e]) * sigm(bflo(gv[it][e])), bfhi(av[it][e]) * sigm(bfhi(gv[it][e])));
                    if (q < 62 * 32) *(LAS u32x4*)(gl + r * 256 + c8) = o;
                }
            }
            __syncthreads();
            {
                float wk[31];
#pragma unroll
                for (int k = 0; k < 31; ++k) wk[k] = cw[k * 256 + c];
                const float bias = p.conf_dw_b[l * 256 + c];
                float g[62];
#pragma unroll
                for (int i = 0; i < 62; ++i) g[i] = bf2f(gl[i * 256 + c]);
#pragma unroll
                for (int tt = 0; tt < 32; ++tt) {
                    float y = bias;
#pragma unroll
                    for (int k = 0; k < 31; ++k) y += wk[k] * g[tt + k];
                    ybuf[tt * 256 + c] = y;
                }
            }
            __syncthreads();
            const f32x4 lng = *(const f32x4*)(p.conf_ln_g + l * 256 + lane * 4), lnb = *(const f32x4*)(p.conf_ln_b + l * 256 + lane * 4);
            u32x2 cgp[8]; f32x4 v[8]; float s1[8], s2[8];
#pragma unroll
            for (int j = 0; j < 8; ++j) {
                const int t = t0 + w * 8 + j, tc = (t < LSEQ) ? t : LSEQ - 1;
                cgp[j] = *(const u32x2*)(zb + (size_t)tc * 2304 + 1024 + lane * 4);
                v[j] = *(LAS f32x4*)(ybuf + (w * 8 + j) * 256 + lane * 4);
                s1[j] = (v[j][0] + v[j][1]) + (v[j][2] + v[j][3]);
            }
#pragma unroll
            for (int j = 0; j < 8; ++j) s1[j] = xadd16(xadd32(s1[j]));
#pragma unroll
            for (int o = 8; o; o >>= 1) {
#pragma unroll
                for (int j = 0; j < 8; ++j) s1[j] += __shfl_xor(s1[j], o);
            }
#pragma unroll
            for (int j = 0; j < 8; ++j) { v[j] = v[j] - s1[j] * (1.f / 256.f); s2[j] = (v[j][0] * v[j][0] + v[j][1] * v[j][1]) + (v[j][2] * v[j][2] + v[j][3] * v[j][3]); }
#pragma unroll
            for (int j = 0; j < 8; ++j) s2[j] = xadd16(xadd32(s2[j]));
#pragma unroll
            for (int o = 8; o; o >>= 1) {
#pragma unroll
                for (int j = 0; j < 8; ++j) s2[j] += __shfl_xor(s2[j], o);
            }
#pragma unroll
            for (int j = 0; j < 8; ++j) {
                const int t = t0 + w * 8 + j;
                const float rstd = rsqrtf(s2[j] * (1.f / 256.f) + EPS);
                if (t < LSEQ) {
                    const f32x4 d = v[j]; const u32x2 cgv = cgp[j];
                    const float o0 = silu(d[0] * rstd * lng[0] + lnb[0]) * silu(bflo(cgv[0]));
                    const float o1 = silu(d[1] * rstd * lng[1] + lnb[1]) * silu(bfhi(cgv[0]));
                    const float o2 = silu(d[2] * rstd * lng[2] + lnb[2]) * silu(bflo(cgv[1]));
                    const float o3 = silu(d[3] * rstd * lng[3] + lnb[3]) * silu(bfhi(cgv[1]));
                    *(u32x2*)(ub + (size_t)t * 1280 + 768 + lane * 4) = (u32x2){pk2(o0, o1), pk2(o2, o3)};
                }
            }
            __syncthreads();
        }
    }
    for (int tile = vblock(); tile < 8 * 129; tile += gridDim.x) {
        const int b = tile / 129, t0 = (tile - b * 129) * 32;
        const bf16_t* zb = zc + (size_t)b * LSEQ * 2304;
        bf16_t* ub = u + (size_t)b * LSEQ * 1280;
        {
            const int win = 2 << w;
            LAS bf16_t* img = (LAS bf16_t*)(lds + 32768);
            u32x4 pgr[4];
            {
                u32x4 vv[6];
#pragma unroll
                for (int it = 0; it < 6; ++it) {
                    const int q = c + 256 * it, r = q >> 5, c8 = (q & 31) * 8, t = t0 - 15 + r;
                    vv[it] = (u32x4){0u, 0u, 0u, 0u};
                    if (q < 47 * 32 && t >= 0 && t < LSEQ) vv[it] = *(const u32x4*)(zb + (size_t)t * 2304 + c8);
                }
#pragma unroll
                for (int it = 0; it < 4; ++it) {
                    const int q = c + 256 * it, r = q >> 5, c8 = (q & 31) * 8, t = t0 + r, tc = (t < LSEQ) ? t : LSEQ - 1;
                    pgr[it] = *(const u32x4*)(zb + (size_t)tc * 2304 + 256 + c8);
                }
#pragma unroll
                for (int it = 0; it < 6; ++it) {
                    const int q = c + 256 * it, r = q >> 5, c8 = (q & 31) * 8;
                    if (q < 47 * 32) *(LAS u32x4*)(img + r * 256 + c8) = vv[it];
                }
            }
            __syncthreads();
            {
                float v[47];
#pragma unroll
                for (int i = 0; i < 47; ++i) v[i] = bf2f(img[i * 256 + c]);
#pragma unroll
                for (int tt = 0; tt < 32; ++tt) {
                    float s = 0.f;
#pragma unroll
                    for (int j = 0; j < 16; ++j) s += (j < win) ? v[tt + 15 - j] : 0.f;
                    const int t = t0 + tt;
                    const float cnt = (float)((t + 1 < win) ? t + 1 : win);
                    ybuf[tt * 256 + c] = s * __builtin_amdgcn_rcpf(cnt) - v[tt + 15];
                }
            }
            __syncthreads();
#pragma unroll
            for (int it = 0; it < 4; ++it) { const int q = c + 256 * it, r = q >> 5, c8 = (q & 31) * 8; *(LAS u32x4*)(img + r * 256 + c8) = pgr[it]; }
            __syncthreads();
            asm volatile("" ::: "memory");
            float W[64];
            const float* pw = p.pool_w + ((size_t)(l * 4 + w) * 64) * 64 + lane;
#pragma unroll
            for (int cc = 0; cc < 64; ++cc) W[cc] = pw[cc * 64];
            const float scale = p.pool_scale[l * 256 + c];
            for (int tt = 0; tt < 32; ++tt) {
                const int t = t0 + tt;
                float y = 0.f;
#pragma unroll
                for (int c4 = 0; c4 < 16; ++c4) {
                    const f32x4 pp = *(LAS f32x4*)(ybuf + tt * 256 + w * 64 + c4 * 4);
                    y += pp[0] * W[4 * c4] + pp[1] * W[4 * c4 + 1] + pp[2] * W[4 * c4 + 2] + pp[3] * W[4 * c4 + 3];
                }
                if (t < LSEQ) ub[(size_t)t * 1280 + c] = f2bf(y * scale * silu(bf2f(img[tt * 256 + c])));
            }
            __syncthreads();
        }
    }
}

DI void phase_qkv(const Params& p, int l, LAS char* lds) {
    const int tidx = otid();
    const bf16_t* zm = (const bf16_t*)(p.ws + OFF_ZM);
    const bf16_t* W = (const bf16_t*)(p.ws + OFF_W) + (size_t)l * W_LAYER;
    bf16_t* Q = (bf16_t*)(p.ws + OFF_Q); bf16_t* Kn = (bf16_t*)(p.ws + OFF_KN); bf16_t* Kr = (bf16_t*)(p.ws + OFF_KR); bf16_t* Vt = (bf16_t*)(p.ws + OFF_VT);
    const float* rope = (const float*)(p.ws + OFF_ROPE);
    const int tid = tidx, lane = tid & 63, w = tid >> 6, wm = w >> 1, wn = w & 1, fr = lane & 15, fq = lane >> 4;
    const float* rsb = (const float*)(p.ws + OFF_RS);
    auto op_of = [&](int i) {
        const int mt = i / 14, nt = i - mt * 14;
        if (nt < 6) return GOp{zm + (size_t)mt * 128 * 1024, W + W_UQ + (size_t)nt * 128 * 256, 1024, 256, 256, mt + nt};
        return GOp{zm + (size_t)mt * 128 * 1024 + 256, W + W_UKV + (size_t)(nt - 6) * 128 * 128, 1024, 128, 128, mt + nt};
    };
    bool inflight = false;
    for (int i = vblock(); i < 257 * 14; i += gridDim.x) {
        const int mt = i / 14, nt = i - mt * 14;
        const bool isq = nt < 6;
        const int m0 = mt * 128;
        const bool has_next = i + (int)gridDim.x < 257 * 14;
        const GOp g = op_of(i), gn = op_of(has_next ? i + (int)gridDim.x : i);
        float rr[4];
#pragma unroll
        for (int mi = 0; mi < 4; ++mi) rr[mi] = rsb[(size_t)(m0 + wm * 64 + mi * 16 + fr) * 2 + (isq ? 0 : 1)];
        f32x4 acc[4][4]; zero_acc(acc);
        gemm_core(acc, g, lds, tidx, inflight, has_next, gn);
        inflight = has_next;
        if (isq) {
            const int cb0 = (nt * 128 + wn * 64) >> 4;
#pragma unroll
            for (int mi = 0; mi < 4; ++mi) {
                const int row = m0 + wm * 64 + mi * 16 + fr;
                const int pos = row % LSEQ;
#pragma unroll
                for (int ni = 0; ni < 4; ++ni) acc[mi][ni] = acc[mi][ni] * rr[mi];
#pragma unroll
                for (int ni = 0; ni < 4; ni += 2) {
                    if ((cb0 + ni) % 6 == 4) {
#pragma unroll
                        for (int r = 0; r < 4; ++r) {
                            const f32x2 cs = *(const f32x2*)(rope + ((size_t)pos * 16 + fq * 4 + r) * 2);
                            const float t1 = acc[mi][ni][r], t2 = acc[mi][ni + 1][r];
                            acc[mi][ni][r] = t1 * cs[0] - t2 * cs[1]; acc[mi][ni + 1][r] = t1 * cs[1] + t2 * cs[0];
                        }
                    }
                }
#pragma unroll
                for (int ni = 0; ni < 4; ++ni) {
                    const int col = nt * 128 + wn * 64 + ni * 16 + fq * 4;
                    *(u32x2*)(Q + (size_t)row * 768 + col) = (u32x2){pk2(acc[mi][ni][0], acc[mi][ni][1]), pk2(acc[mi][ni][2], acc[mi][ni][3])};
                }
            }
        } else {
            const int ntk = nt - 6;
            const int cbase = ntk * 128 + wn * 64, hd = cbase >> 7, isv = (cbase >> 6) & 1;
#pragma unroll
            for (int mi = 0; mi < 4; ++mi) {
                const int row = m0 + wm * 64 + mi * 16 + fr;
                const int b = row / LSEQ, t = row - b * LSEQ;
#pragma unroll
                for (int ni = 0; ni < 4; ++ni) {
                    const f32x4 v = acc[mi][ni] * rr[mi];
                    const int d = ni * 16 + fq * 4;
                    if (!isv) {
                        *(u32x2*)(Kn + (size_t)row * 512 + hd * 64 + d) = (u32x2){pk2(v[0], v[1]), pk2(v[2], v[3])};
                    } else {
                        bf16_t* vp = Vt + ((size_t)((b * 8 + hd) * 64 + d)) * LP + t;
                        vp[0] = f2bf(v[0]); vp[LP] = f2bf(v[1]); vp[2 * LP] = f2bf(v[2]); vp[3 * LP] = f2bf(v[3]);
                    }
                }
            }
        }
    }
    for (int i = blockIdx.x * 256 + tid; i < MTOK * 16; i += gridDim.x * 256) {
        const int row = i >> 4, j = i & 15, pos = row % LSEQ;
        const bf16_t* kr = zm + (size_t)row * 1024 + 384;
        const float t1 = bf2f(kr[j]), t2 = bf2f(kr[16 + j]);
        const f32x2 cs = *(const f32x2*)(rope + ((size_t)pos * 16 + j) * 2);
        Kr[(size_t)row * 32 + j] = f2bf(t1 * cs[0] - t2 * cs[1]);
        Kr[(size_t)row * 32 + 16 + j] = f2bf(t1 * cs[1] + t2 * cs[0]);
    }
    for (int i = blockIdx.x * 256 + tid; i < 64 * 64 * (LP - LSEQ); i += gridDim.x * 256) {
        const int r = i / (LP - LSEQ), k = i - r * (LP - LSEQ);
        Vt[(size_t)r * LP + LSEQ + k] = 0;
    }
}

DI int crow(int r, int hh) { return (r & 3) + 8 * (r >> 2) + 4 * hh; }
DI void phase_attn(const Params& p, int l, LAS char* lds) {
    const int tidx = otid();
    const bf16_t* Q = (const bf16_t*)(p.ws + OFF_Q); const bf16_t* Kn = (const bf16_t*)(p.ws + OFF_KN);
    const bf16_t* Kr = (const bf16_t*)(p.ws + OFF_KR); const bf16_t* Vt = (const bf16_t*)(p.ws + OFF_VT);
    const bf16_t* zm = (const bf16_t*)(p.ws + OFF_ZM);
    bf16_t* u = (bf16_t*)(p.ws + OFF_U);
    const int tid = tidx, lane = tid & 63, w = tid >> 6, qi = lane & 31, hh = lane >> 5;
    const int G = gridDim.x;
    constexpr int NUNITS = 64 * 33;
    int krow_[3], kc_[3];
#pragma unroll
    for (int j = 0; j < 3; ++j) {
        const int o = (j * 4 + w) * 1024 + lane * 16;
        krow_[j] = o / 192; const int cs = (o - krow_[j] * 192) >> 4; kc_[j] = cs ^ ((krow_[j] >> 2) & 3);
    }
    int vrow_[2], vc_[2];
#pragma unroll
    for (int j = 0; j < 2; ++j) {
        const int o = (j * 4 + w) * 1024 + lane * 16;
        vrow_[j] = o >> 7; const int cs = (o >> 4) & 7; vc_[j] = cs ^ ((vrow_[j] >> 1) & 7);
    }
    const int ksw = (qi >> 2) & 3;
    const int vsw = (qi >> 1) & 7;
    for (int k = 0; k * G < NUNITS; ++k) {
        const int unit = k * G + ((k & 1) ? (G - 1 - (int)blockIdx.x) : (int)blockIdx.x);
        if (unit >= NUNITS) continue;
        const int qt = 32 - unit / 64, bh = unit & 63, b = bh >> 3, hd = bh & 7;
        const int q0w = qt * 128 + w * 32;
        const int nkt = (2 * qt + 2 < 65) ? 2 * qt + 2 : 65;
        bf16x8 qf[6];
        {
            const int tq = (q0w + qi < LSEQ) ? q0w + qi : LSEQ - 1;
            const bf16_t* qp = Q + ((size_t)(b * LSEQ + tq)) * 768 + hd * 96 + 8 * hh;
#pragma unroll
            for (int s = 0; s < 6; ++s) qf[s] = *(const bf16x8*)(qp + 16 * s);
        }
        const bf16_t* Knb = Kn + (size_t)b * LSEQ * 512 + hd * 64;
        const bf16_t* Krb = Kr + (size_t)b * LSEQ * 32;
        const bf16_t* Vtb = Vt + (size_t)bh * 64 * LP;
        auto issue = [&](int stage, int kt) {
            LAS char* base = lds + stage * 20480 + w * 1024;
#pragma unroll
            for (int j = 0; j < 3; ++j) {
                int tk = kt * 64 + krow_[j]; tk = (tk < LSEQ) ? tk : LSEQ - 1;
                const bf16_t* src = (kc_[j] < 8) ? Knb + (size_t)tk * 512 + kc_[j] * 8 : Krb + (size_t)tk * 32 + (kc_[j] - 8) * 8;
                gload_lds16(src, base + j * 4096);
            }
#pragma unroll
            for (int j = 0; j < 2; ++j) gload_lds16(Vtb + (size_t)vrow_[j] * LP + kt * 64 + vc_[j] * 8, base + 12288 + j * 4096);
        };
        f32x16 o0, o1;
#pragma unroll
        for (int r = 0; r < 16; ++r) { o0[r] = 0.f; o1[r] = 0.f; }
        float m_run = -INFINITY, l_run = 0.f;
        issue(0, 0);
        for (int kt = 0; kt < nkt; ++kt) {
            asm volatile("s_waitcnt vmcnt(0)" ::: "memory");
            __syncthreads();
            if (kt + 1 < nkt) issue((kt + 1) & 1, kt + 1);
            if (kt * 64 > q0w + 31) continue;
            LAS char* st = lds + (kt & 1) * 20480;
            f32x16 s0, s1;
#pragma unroll
            for (int r = 0; r < 16; ++r) { s0[r] = 0.f; s1[r] = 0.f; }
#pragma unroll
            for (int s = 0; s < 6; ++s) {
                const int pos = ((2 * s + hh) ^ ksw) << 4;
                const bf16x8 k0 = *(LAS bf16x8*)(st + qi * 192 + pos);
                const bf16x8 k1 = *(LAS bf16x8*)(st + (qi + 32) * 192 + pos);
                s0 = __builtin_amdgcn_mfma_f32_32x32x16_bf16(k0, qf[s], s0, 0, 0, 0);
                s1 = __builtin_amdgcn_mfma_f32_32x32x16_bf16(k1, qf[s], s1, 0, 0, 0);
            }
            if (kt * 64 + 63 > q0w) {
                const int qpos = q0w + qi;
#pragma unroll
                for (int r = 0; r < 16; ++r) {
                    const int key = kt * 64 + crow(r, hh);
                    if (key > qpos) s0[r] = -INFINITY;
                    if (key + 32 > qpos) s1[r] = -INFINITY;
                }
            }
            __builtin_amdgcn_s_setprio(1);
            float mx = s0[0];
#pragma unroll
            for (int r = 1; r < 16; ++r) mx = fmaxf(mx, s0[r]);
#pragma unroll
            for (int r = 0; r < 16; ++r) mx = fmaxf(mx, s1[r]);
            {
                const auto rr = __builtin_amdgcn_permlane32_swap(__float_as_uint(mx), __float_as_uint(mx), false, false);
                mx = fmaxf(__uint_as_float(rr[0]), __uint_as_float(rr[1]));
            }
            float m_new = m_run;
            if (__builtin_amdgcn_ballot_w64(mx - m_run > 8.f) != 0ull) {
                m_new = fmaxf(m_run, mx);
                const float alpha = __builtin_amdgcn_exp2f(m_run - m_new);
                m_run = m_new;
                l_run *= alpha;
#pragma unroll
                for (int r = 0; r < 16; ++r) { o0[r] *= alpha; o1[r] *= alpha; }
            }
            float ps = 0.f;
#pragma unroll
            for (int r = 0; r < 16; ++r) { s0[r] = __builtin_amdgcn_exp2f(s0[r] - m_new); s1[r] = __builtin_amdgcn_exp2f(s1[r] - m_new); ps += s0[r] + s1[r]; }
            l_run += ps;
            bf16x8 pf[2][2];
#pragma unroll
            for (int s2 = 0; s2 < 2; ++s2) {
                u32x4 a, c2;
#pragma unroll
                for (int e = 0; e < 4; ++e) { a[e] = pk2(s0[8 * s2 + 2 * e], s0[8 * s2 + 2 * e + 1]); c2[e] = pk2(s1[8 * s2 + 2 * e], s1[8 * s2 + 2 * e + 1]); }
                pf[0][s2] = __builtin_bit_cast(bf16x8, a); pf[1][s2] = __builtin_bit_cast(bf16x8, c2);
            }
            LAS char* vs = st + 12288;
            __builtin_amdgcn_s_setprio(0);
#pragma unroll
            for (int tl = 0; tl < 2; ++tl)
#pragma unroll
                for (int s2 = 0; s2 < 2; ++s2) {
                    const int c = 4 * tl + 2 * s2;
                    const int p0 = ((c ^ vsw) << 4) + 8 * hh, p1 = (((c + 1) ^ vsw) << 4) + 8 * hh;
                    const s16x4 a0 = *(LAS s16x4*)(vs + qi * 128 + p0), a1 = *(LAS s16x4*)(vs + qi * 128 + p1);
                    const s16x4 b0 = *(LAS s16x4*)(vs + (qi + 32) * 128 + p0), b1 = *(LAS s16x4*)(vs + (qi + 32) * 128 + p1);
                    const bf16x8 v0 = __builtin_shufflevector(a0, a1, 0, 1, 2, 3, 4, 5, 6, 7);
                    const bf16x8 v1 = __builtin_shufflevector(b0, b1, 0, 1, 2, 3, 4, 5, 6, 7);
                    o0 = __builtin_amdgcn_mfma_f32_32x32x16_bf16(v0, pf[tl][s2], o0, 0, 0, 0);
                    o1 = __builtin_amdgcn_mfma_f32_32x32x16_bf16(v1, pf[tl][s2], o1, 0, 0, 0);
                }
        }
        __syncthreads();
        const float lt = l_run + __shfl_xor(l_run, 32);
        const float inv = 1.f / lt;
        const int t = q0w + qi;
        if (t < LSEQ) {
            const size_t row = (size_t)b * LSEQ + t;
            const bf16_t* mg = zm + row * 1024 + 416 + hd * 64;
            bf16_t* dst = u + row * 1280 + 256 + hd * 64;
#pragma unroll
            for (int g = 0; g < 4; ++g) {
                const int d = 8 * g + 4 * hh;
                const u32x2 g0 = *(const u32x2*)(mg + d), g1 = *(const u32x2*)(mg + 32 + d);
                *(u32x2*)(dst + d) = (u32x2){pk2(o0[4 * g] * inv * silu(bflo(g0[0])), o0[4 * g + 1] * inv * silu(bfhi(g0[0]))),
                                             pk2(o0[4 * g + 2] * inv * silu(bflo(g0[1])), o0[4 * g + 3] * inv * silu(bfhi(g0[1])))};
                *(u32x2*)(dst + 32 + d) = (u32x2){pk2(o1[4 * g] * inv * silu(bflo(g1[0])), o1[4 * g + 1] * inv * silu(bfhi(g1[0]))),
                                                  pk2(o1[4 * g + 2] * inv * silu(bflo(g1[1])), o1[4 * g + 3] * inv * silu(bfhi(g1[1])))};
            }
        }
    }
}

DI void phase_merge(const Params& p, int l, LAS char* lds) {
    const int tidx = otid();
    const bf16_t* h = (const bf16_t*)(p.ws + OFF_H);
    const bf16_t* u = (const bf16_t*)(p.ws + OFF_U);
    const bf16_t* W = (const bf16_t*)(p.ws + OFF_W) + (size_t)l * W_LAYER;
    bf16_t* m = (bf16_t*)(p.ws + OFF_ZM);
    const float* gb = p.gate_bias + l * 4096;
    const int lane = tidx & 63, w = tidx >> 6, wm = w >> 1, wn = w & 1, fr = lane & 15, fq = lane >> 4;
    unsigned* stash = (unsigned*)(p.ws + OFF_ZC) + tidx;
    const int G = gridDim.x, NT = 257 * 8, vb = vblock();
    const int ntl = (vb < NT) ? (NT - vb + G - 1) / G : 0;
    const int nops = 8 * ntl;
    auto op_of = [&](int f) {
        if (f < 4 * ntl) {
            const int br = f / ntl, i = vb + (f - br * ntl) * G, mt = i >> 3, nt = i & 7;
            return GOp{h + (size_t)mt * 128 * 1024, W + W_IN + (size_t)(3328 + br * 1024 + nt * 128) * 1024, 1024, 1024, 1024, 2 * (mt + nt)};
        }
        const int f2 = f - 4 * ntl, k = f2 >> 2, br = f2 & 3, i = vb + k * G, mt = i >> 3, nt = i & 7;
        const int koff = (br == 0) ? 0 : (br == 1) ? 256 : (br == 2) ? 768 : 1024;
        const int kk = (br == 1) ? 512 : 256;
        const size_t woff = (br == 0) ? W_OP : (br == 1) ? W_OM : (br == 2) ? W_OC : W_OS;
        return GOp{u + (size_t)mt * 128 * 1280 + koff, W + woff + (size_t)nt * 128 * kk, 1280, kk, kk, mt + nt};
    };
    f32x4 acc[4][4];
    bool inflight = false;
    unsigned sq[4][4], sqn[4][4];
#pragma unroll
    for (int mi = 0; mi < 4; ++mi)
#pragma unroll
        for (int ni = 0; ni < 4; ++ni) { sq[mi][ni] = 0x01010101u; sqn[mi][ni] = 0x01010101u; }
    for (int f = 0; f < nops; ++f) {
        const bool gate = f < 4 * ntl;
        int br, i;
        if (gate) { br = f / ntl; i = vb + (f - br * ntl) * G; } else { const int f2 = f - 4 * ntl; br = f2 & 3; i = vb + (f2 >> 2) * G; }
        const int mt = i >> 3, nt = i & 7;
        const bool has_next = f + 1 < nops;
        const GOp g = op_of(f), gn = op_of(has_next ? f + 1 : f);
        unsigned* st = stash + (size_t)(i * 4 + br) * 4096;
        if (gate || br == 0) zero_acc(acc);
        if (!gate) {
#pragma unroll
            for (int mi = 0; mi < 4; ++mi)
#pragma unroll
                for (int ni = 0; ni < 4; ++ni) sq[mi][ni] = sqn[mi][ni];
            if (br > 0) {
#pragma unroll
                for (int mi = 0; mi < 4; ++mi)
#pragma unroll
                    for (int ni = 0; ni < 4; ++ni) {
                        const unsigned q = sq[mi][ni];
                        acc[mi][ni][0] *= 255.f * __builtin_amdgcn_rcpf((float)(q & 0xffu)); acc[mi][ni][1] *= 255.f * __builtin_amdgcn_rcpf((float)((q >> 8) & 0xffu));
                        acc[mi][ni][2] *= 255.f * __builtin_amdgcn_rcpf((float)((q >> 16) & 0xffu)); acc[mi][ni][3] *= 255.f * __builtin_amdgcn_rcpf((float)(q >> 24));
                    }
            }
        }
        if (has_next && f + 1 >= 4 * ntl) {
            const int f2 = f + 1 - 4 * ntl;
            const unsigned* stn = stash + (size_t)((vb + (f2 >> 2) * G) * 4 + (f2 & 3)) * 4096;
#pragma unroll
            for (int mi = 0; mi < 4; ++mi)
#pragma unroll
                for (int ni = 0; ni < 4; ++ni) sqn[mi][ni] = stn[(mi * 4 + ni) * 256];
        }
        f32x4 bvv[4];
        if (gate) {
#pragma unroll
            for (int ni = 0; ni < 4; ++ni) bvv[ni] = *(const f32x4*)(gb + br * 1024 + nt * 128 + wn * 64 + ni * 16 + fq * 4);
        }
        gemm_core(acc, g, lds, tidx, inflight, has_next, gn);
        inflight = has_next;
        if (gate) {
#pragma unroll
            for (int ni = 0; ni < 4; ++ni) {
                const f32x4 bv = bvv[ni];
#pragma unroll
                for (int mi = 0; mi < 4; ++mi) {
                    const f32x4 a = acc[mi][ni] + bv;
                    const unsigned q0 = (unsigned)(fmaxf(sigm(a[0]) * 255.f, 1.f) + 0.5f), q1 = (unsigned)(fmaxf(sigm(a[1]) * 255.f, 1.f) + 0.5f);
                    const unsigned q2 = (unsigned)(fmaxf(sigm(a[2]) * 255.f, 1.f) + 0.5f), q3 = (unsigned)(fmaxf(sigm(a[3]) * 255.f, 1.f) + 0.5f);
                    st[(mi * 4 + ni) * 256] = q0 | (q1 << 8) | (q2 << 16) | (q3 << 24);
                }
            }
        } else {
            const float c = 1.f / 255.f;
#pragma unroll
            for (int mi = 0; mi < 4; ++mi)
#pragma unroll
                for (int ni = 0; ni < 4; ++ni) {
                    const unsigned q = sq[mi][ni];
                    acc[mi][ni][0] *= c * (float)(q & 0xffu); acc[mi][ni][1] *= c * (float)((q >> 8) & 0xffu);
                    acc[mi][ni][2] *= c * (float)((q >> 16) & 0xffu); acc[mi][ni][3] *= c * (float)(q >> 24);
                }
            if (br == 3) {
#pragma unroll
                for (int mi = 0; mi < 4; ++mi) {
                    const int row = mt * 128 + wm * 64 + mi * 16 + fr;
                    store_row_wide(m + (size_t)row * 1024 + nt * 128 + wn * 64, acc[mi], fq);
                }
            }
        }
    }
}

DI void phase_wo(const Params& p, int l, LAS char* lds) {
    const int tidx = otid();
    const bf16_t* m = (const bf16_t*)(p.ws + OFF_ZM);
    const bf16_t* W = (const bf16_t*)(p.ws + OFF_W) + (size_t)l * W_LAYER + W_O;
    bf16_t* o = (bf16_t*)(p.ws + OFF_H);
    const int lane = tidx & 63, w = tidx >> 6, wm = w >> 1, wn = w & 1, fr = lane & 15, fq = lane >> 4;
    auto op_of = [&](int i) { const int mt = i >> 3, nt = i & 7; return GOp{m + (size_t)mt * 128 * 1024, W + (size_t)nt * 128 * 1024, 1024, 1024, 1024, 2 * (mt + nt)}; };
    bool inflight = false;
    for (int i = vblock(); i < 257 * 8; i += gridDim.x) {
        const int mt = i >> 3, nt = i & 7;
        const bool has_next = i + (int)gridDim.x < 257 * 8;
        const GOp g = op_of(i), gn = op_of(has_next ? i + (int)gridDim.x : i);
        f32x4 acc[4][4]; zero_acc(acc);
        gemm_core<true>(acc, g, lds, tidx, inflight, has_next, gn, true);
        inflight = has_next;
#pragma unroll
        for (int mi = 0; mi < 4; ++mi) {
            const int row = mt * 128 + wm * 64 + mi * 16 + fr;
            store_row_wide(o + (size_t)row * 1024 + nt * 128 + wn * 64, acc[mi], fq);
        }
    }
}


#define XB_TMO      128
#define XB_XCNT(j)  (256  + 64 * (j))
#define XB_XSUB(j)  (1280 + 64 * (j))
#define XB_XGEN(j)  (2304 + 64 * (j))
#define XB_TOP      3328
#define XB_TOPGEN   3392
#define XCD_BAR_WORDS 3456
#define XB_SPIN_CAP (1u << 22)
DI unsigned xb_ld(unsigned* p) { return __hip_atomic_load(p, __ATOMIC_RELAXED, __HIP_MEMORY_SCOPE_AGENT); }
DI unsigned xb_add(unsigned* p, unsigned v) { return __hip_atomic_fetch_add(p, v, __ATOMIC_RELAXED, __HIP_MEMORY_SCOPE_AGENT); }
DI unsigned xb_xcc_id() { return (unsigned)__builtin_amdgcn_s_getreg((3 << 11) | 20) & 0xFu; }
#define XB_SPIN(cond, bar) do { unsigned _sp = 0; while (cond) { __builtin_amdgcn_s_sleep(1); \
    if ((++_sp & 255u) == 0u) { if (xb_ld(&(bar)[XB_TMO])) break; if (_sp > XB_SPIN_CAP) { atomicAdd(&(bar)[XB_TMO], 1u); break; } } } } while (0)
struct XcdBarrier { unsigned* bar; unsigned x; unsigned nloc, nx; };
DI XcdBarrier xcd_barrier_post(unsigned* bar) {
    XcdBarrier b; b.bar = bar; b.x = xb_xcc_id(); b.nloc = 0u; b.nx = 0u;
    if (threadIdx.x == 0) (void)xb_add(&bar[XB_XCNT(b.x)], 1u);
    return b;
}
DI void xcd_barrier_complete(unsigned* bar, unsigned x, unsigned& nloc, unsigned& nx) {
    const unsigned G = gridDim.x * gridDim.y * gridDim.z;
    unsigned sum, cnt, mine, sp = 0u;
    for (;;) {
        sum = 0u; cnt = 0u; mine = 0u;
#pragma unroll
        for (unsigned j = 0; j < 16; ++j) { const unsigned c = xb_ld(&bar[XB_XCNT(j)]); sum += c; cnt += (c > 0u) ? 1u : 0u; mine = (j == x) ? c : mine; }
        if (sum == G) break;
        __builtin_amdgcn_s_sleep(1);
        if ((++sp & 255u) == 0u) { if (xb_ld(&bar[XB_TMO])) break; if (sp > XB_SPIN_CAP) { atomicAdd(&bar[XB_TMO], 1u); break; } }
    }
    nloc = mine > 0u ? mine : 1u; nx = cnt > 0u ? cnt : 1u;
}
DI void xcd_barrier(XcdBarrier& b) {
    asm volatile("s_waitcnt vmcnt(0)" ::: "memory");
    __syncthreads();
    if (threadIdx.x == 0) {
        unsigned* bar = b.bar;
        __builtin_amdgcn_s_waitcnt(0);
        if (b.nloc == 0u) xcd_barrier_complete(bar, b.x, b.nloc, b.nx);
        const unsigned nloc = b.nloc, nx = b.nx;
        const unsigned old = xb_add(&bar[XB_XSUB(b.x)], 1u);
        const unsigned gen = old / nloc;
        if (old + 1u == (gen + 1u) * nloc) {
            __builtin_amdgcn_fence(__ATOMIC_RELEASE, "agent");
            asm volatile("s_waitcnt vmcnt(0)" ::: "memory");
            const unsigned og = xb_add(&bar[XB_TOP], 1u);
            const unsigned tg = og / nx;
            if (og + 1u == (tg + 1u) * nx) xb_add(&bar[XB_TOPGEN], 1u);
            else XB_SPIN(xb_ld(&bar[XB_TOPGEN]) == tg, bar);
            __builtin_amdgcn_fence(__ATOMIC_ACQUIRE, "agent");
            xb_add(&bar[XB_XGEN(b.x)], 1u);
            asm volatile("s_waitcnt vmcnt(0)" ::: "memory");
        } else {
            XB_SPIN(xb_ld(&bar[XB_XGEN(b.x)]) == gen, bar);
            __builtin_amdgcn_fence(__ATOMIC_ACQUIRE, "agent");
            asm volatile("s_waitcnt vmcnt(0)" ::: "memory");
        }
    }
    __syncthreads();
}

constexpr int NPHASE = 1 + 7 * NLAYER;
__global__ void __launch_bounds__(256, 2) mega(Params p) {
    __shared__ __attribute__((aligned(16))) char smem[65536];
    LAS char* lds = (LAS char*)smem;
    cg::grid_group grid = cg::this_grid();
    XcdBarrier xb = xcd_barrier_post((unsigned*)(p.ws + OFF_BAR));
    for (int ph = p.phase_lo; ph <= p.phase_hi; ++ph) {
        if (ph == 0) phase_init(p, lds);
        else {
            const int l = (ph - 1) / 7, s = (ph - 1) % 7;
            switch (s) {
                case 0: for (int r = 0; r < REP_IN; ++r) phase_gemm_in(p, l, lds); break;
                case 1: for (int r = 0; r < REP_MIX; ++r) phase_mixers(p, l, lds); break;
                case 2: for (int r = 0; r < REP_QKV; ++r) phase_qkv(p, l, lds); break;
                case 3: for (int r = 0; r < REP_ATTN; ++r) phase_attn(p, l, lds); break;
                case 4: for (int r = 0; r < REP_MERGE; ++r) phase_merge(p, l, lds); break;
                case 5: for (int r = 0; r < REP_WO; ++r) phase_wo(p, l, lds); break;
                default: phase_norm(p, l, 1); break;
            }
        }
        if (ph < p.phase_hi) { if (p.phase_lo < 0) grid.sync(); else xcd_barrier(xb); }
    }
}

extern "C" void kernel_launch(void* const* d_in, const int* in_sizes, int n_in, void* d_out, int out_size, void* d_ws, size_t ws_size, hipStream_t stream) {
    static int grid_blocks = 0;
    if (!grid_blocks) {
        int dev = 0, cus = 0, per_cu = 0;
        hipGetDevice(&dev);
        hipDeviceGetAttribute(&cus, hipDeviceAttributeMultiprocessorCount, dev);
        hipOccupancyMaxActiveBlocksPerMultiprocessor(&per_cu, mega, 256, 0);
        if (per_cu > 2) per_cu = 2;
        if (per_cu < 1) per_cu = 1;
        grid_blocks = cus * per_cu;
        if (grid_blocks > 512) grid_blocks = 512;
    }
    Params p{};
    const float** f = (const float**)&p;
    for (int i = 0; i < 22; ++i) f[i] = (const float*)d_in[i];
    p.out = (float*)d_out; p.ws = (char*)d_ws;
    if (ws_size < OFF_END) { fprintf(stderr, "workspace too small: %zu < %zu\n", ws_size, (size_t)OFF_END); return; }
#if MULTI_LAUNCH
    for (int ph = 0; ph < NPHASE; ++ph) {
        p.phase_lo = ph; p.phase_hi = ph;
        hipLaunchKernelGGL(mega, dim3(grid_blocks), dim3(256), 0, stream, p);
    }
#else
    p.phase_lo = 0; p.phase_hi = NPHASE - 1;
    (void)hipMemsetAsync((char*)d_ws + OFF_BAR, 0, 16384, stream);
    void* args[] = {&p};
    hipError_t e = hipLaunchCooperativeKernel((void*)mega, dim3(grid_blocks), dim3(256), args, 0, stream);
    if (e != hipSuccess) fprintf(stderr, "cooperative launch failed: %s (grid %d)\n", hipGetErrorString(e), grid_blocks);
#endif
}
```
